# Optimizing an MI355X kernel written in HIP

```python
import math
import jax, jax.numpy as jnp
from jax import lax
import numpy as np

D_MODEL = 1024
BATCH = 16
SEQ = 2048
DEPTH = 2

CHUNK = 64
Q_BLOCK = 128

MLA_HEADS = 8
MLA_NOPE = 64
MLA_ROPE = 32
MLA_V = 64
MLA_Q_RANK = 256
MLA_KV_RANK = 128
ROPE_THETA = 10000.0

CONV_GROUPS = 4
CONV_GROUP_WIDTH = 64
CONV_CH = CONV_GROUPS * CONV_GROUP_WIDTH
CONV_WIDTH = 3

SB_HEADS = 4
SB_HEAD_DIM = 64
SB_WIDTH = SB_HEADS * SB_HEAD_DIM

D_MIX = MLA_HEADS * MLA_V + CONV_CH + SB_WIDTH
IN_SIZES = (MLA_Q_RANK, MLA_KV_RANK, MLA_ROPE,
            CONV_CH, CONV_CH, CONV_CH,
            SB_WIDTH, SB_WIDTH, SB_WIDTH)
IN_COLS = sum(IN_SIZES)
IN_SPLITS = tuple(int(v) for v in np.cumsum(IN_SIZES)[:-1])

PEER_HEADS = 8
PEER_N_KEYS = 128
PEER_N_EXPERTS = PEER_N_KEYS * PEER_N_KEYS
PEER_D_KEY = 256
PEER_HALF = PEER_D_KEY // 2
PEER_TOPK = 16
PEER_TOKEN_BLOCK = 128

LN_EPS = 1e-5
RMS_EPS = 1e-6
DEEPNORM_ALPHA = (2.0 * DEPTH) ** 0.25
DEEPNORM_BETA = (8.0 * DEPTH) ** -0.25
NEG_INF = -1e30

kernel_name = "hybrid_mla_conv_stickbreak_peer_encoder"


def _layer_norm(x, gain, bias):
    xf = x.astype(jnp.float32)
    mu = jnp.mean(xf, axis=-1, keepdims=True)
    var = jnp.mean(jnp.square(xf - mu), axis=-1, keepdims=True)
    y = (xf - mu) * lax.rsqrt(var + LN_EPS) * gain.astype(jnp.float32) + bias.astype(jnp.float32)
    return y.astype(x.dtype)


def _modulate(x, shift, scale):
    xf = x.astype(jnp.float32)
    mu = jnp.mean(xf, axis=-1, keepdims=True)
    var = jnp.mean(jnp.square(xf - mu), axis=-1, keepdims=True)
    y = ((xf - mu) * lax.rsqrt(var + LN_EPS)).astype(x.dtype)
    return y * (1.0 + scale[:, None, :]) + shift[:, None, :]


def _rms_norm(x, gain):
    xf = x.astype(jnp.float32)
    y = xf * lax.rsqrt(jnp.mean(jnp.square(xf), axis=-1, keepdims=True) + RMS_EPS)
    return (y * gain.astype(jnp.float32)).astype(x.dtype)


def _rope(x, positions):
    half = x.shape[-1] // 2
    inv_freq = ROPE_THETA ** (-jnp.arange(half, dtype=jnp.float32) / half)
    ang = positions.astype(jnp.float32)[..., None] * inv_freq
    cos = jnp.cos(ang)[:, :, None, :]
    sin = jnp.sin(ang)[:, :, None, :]
    xf = x.astype(jnp.float32)
    x1, x2 = xf[..., :half], xf[..., half:]
    out = jnp.concatenate([x1 * cos - x2 * sin, x2 * cos + x1 * sin], axis=-1)
    return out.astype(x.dtype)


def _mla_attention(q_nope, q_rope, k_nope, k_rope, v):
    S = q_nope.shape[1]
    scale = (MLA_NOPE + MLA_ROPE) ** -0.5
    outs = []
    for i in range(S // Q_BLOCK):
        q0, q1 = i * Q_BLOCK, (i + 1) * Q_BLOCK
        kv_end = q1
        s = (jnp.einsum('bqhd,bkhd->bhqk', q_nope[:, q0:q1], k_nope[:, :kv_end])
             + jnp.einsum('bqhr,bkr->bhqk', q_rope[:, q0:q1], k_rope[:, :kv_end]))
        s = s.astype(jnp.float32) * scale
        q_chunk = (q0 + jnp.arange(Q_BLOCK)) // CHUNK
        k_chunk = jnp.arange(kv_end) // CHUNK
        mask = k_chunk[None, :] <= q_chunk[:, None]
        p = jax.nn.softmax(jnp.where(mask, s, NEG_INF), axis=-1)
        outs.append(jnp.einsum('bhqk,bkhd->bqhd', p.astype(v.dtype), v[:, :kv_end]))
    return jnp.concatenate(outs, axis=1)


def _stick_breaking(q, k, v):
    S = q.shape[1]
    scale = SB_HEAD_DIM ** -0.5
    outs = []
    for i in range(S // Q_BLOCK):
        q0, q1 = i * Q_BLOCK, (i + 1) * Q_BLOCK
        kv_end = q1
        z = jnp.einsum('bqhd,bkhd->bhqk', q[:, q0:q1], k[:, :kv_end]).astype(jnp.float32) * scale
        q_pos = q0 + jnp.arange(Q_BLOCK)
        k_pos = jnp.arange(kv_end)
        strict = k_pos[None, :] < q_pos[:, None]
        log_beta = jax.nn.log_sigmoid(z)
        log_one_minus = jnp.where(strict, jax.nn.log_sigmoid(-z), 0.0)
        after = lax.cumsum(log_one_minus, axis=3, reverse=True) - log_one_minus
        w = jnp.where(strict, jnp.exp(log_beta + after), 0.0)
        outs.append(jnp.einsum('bhqk,bkhd->bqhd', w.astype(v.dtype), v[:, :kv_end]))
    return jnp.concatenate(outs, axis=1)


def _short_conv(h, gate_b, gate_c, conv_w):
    u = gate_c * h
    S = u.shape[1]
    u_pad = jnp.pad(u, ((0, 0), (CONV_WIDTH - 1, 0), (0, 0)))
    y = conv_w[0] * u_pad[:, 0:S]
    for tap in range(1, CONV_WIDTH):
        y = y + conv_w[tap] * u_pad[:, tap:tap + S]
    return gate_b * y


def _hybrid_mixer(h, positions, w_in, q_norm_g, kv_norm_g, w_uq, w_ukv, conv_w, w_o):
    Bb, S, _ = h.shape
    proj = h @ w_in
    q_lat, kv_lat, k_rope, c_b, c_c, c_h, sb_q, sb_k, sb_v = jnp.split(proj, IN_SPLITS, axis=-1)
    q = (_rms_norm(q_lat, q_norm_g) @ w_uq).reshape(Bb, S, MLA_HEADS, MLA_NOPE + MLA_ROPE)
    q_nope = q[..., :MLA_NOPE]
    q_rope = _rope(q[..., MLA_NOPE:], positions)
    kv = (_rms_norm(kv_lat, kv_norm_g) @ w_ukv).reshape(Bb, S, MLA_HEADS, MLA_NOPE + MLA_V)
    k_nope, v = kv[..., :MLA_NOPE], kv[..., MLA_NOPE:]
    k_rope = _rope(k_rope[:, :, None, :], positions)[:, :, 0, :]
    mla_o = _mla_attention(q_nope, q_rope, k_nope, k_rope, v).reshape(Bb, S, MLA_HEADS * MLA_V)
    conv_o = _short_conv(c_h, c_b, c_c, conv_w)
    shp = (Bb, S, SB_HEADS, SB_HEAD_DIM)
    sb_o = _stick_breaking(sb_q.reshape(shp), sb_k.reshape(shp), sb_v.reshape(shp)).reshape(Bb, S, SB_WIDTH)
    return jnp.concatenate([mla_o, conv_o, sb_o], axis=-1) @ w_o


def _peer(h, wq, sub_k1, sub_k2, u_tab, v_tab):
    Bb, S, D = h.shape
    q = (h @ wq).reshape(Bb, S, PEER_HEADS, 2, PEER_HALF)
    s1 = jnp.einsum('bshd,hnd->bshn', q[..., 0, :], sub_k1).astype(jnp.float32)
    s2 = jnp.einsum('bshd,hnd->bshn', q[..., 1, :], sub_k2).astype(jnp.float32)
    v1, i1 = lax.top_k(s1, PEER_TOPK)
    v2, i2 = lax.top_k(s2, PEER_TOPK)
    cand_s = (v1[..., :, None] + v2[..., None, :]).reshape(Bb, S, PEER_HEADS, PEER_TOPK * PEER_TOPK)
    cand_e = (i1[..., :, None] * PEER_N_KEYS + i2[..., None, :]).reshape(Bb, S, PEER_HEADS, PEER_TOPK * PEER_TOPK)
    top_s, pos = lax.top_k(cand_s, PEER_TOPK)
    experts = jnp.take_along_axis(cand_e, pos, axis=-1)
    g = jax.nn.softmax(top_s, axis=-1)
    T = Bb * S
    nblk = T // PEER_TOKEN_BLOCK
    hf = h.reshape(nblk, PEER_TOKEN_BLOCK, D)
    ef = experts.reshape(nblk, PEER_TOKEN_BLOCK, PEER_HEADS * PEER_TOPK)
    gf = g.reshape(nblk, PEER_TOKEN_BLOCK, PEER_HEADS * PEER_TOPK).astype(h.dtype)

    def token_block(args):
        hb, eb, gb = args
        u = jnp.take(u_tab, eb, axis=0)
        act = jax.nn.gelu(jnp.einsum('tkd,td->tk', u, hb), approximate=False)
        vv = jnp.take(v_tab, eb, axis=0)
        return jnp.einsum('tk,tkd->td', gb * act, vv)

    out = lax.map(token_block, (hf, ef, gf))
    return out.reshape(Bb, S, D)


def setup_inputs(seed: int = 0) -> dict:
    key = jax.random.key(seed)
    ks = jax.random.split(key, 24)
    D, L = D_MODEL, DEPTH

    def nrm(k, shape, std):
        return jax.random.normal(k, shape, jnp.float32) * std

    x = nrm(ks[0], (BATCH, SEQ, D), 1.0)
    c = nrm(ks[1], (BATCH, D), 1.0)
    offset = jax.random.randint(ks[2], (BATCH, 1), 0, 4096, dtype=jnp.int32)
    positions = offset + jnp.arange(SEQ, dtype=jnp.int32)[None, :]
    ada_w = nrm(ks[3], (L, D, 6 * D), 0.5 * D ** -0.5)
    ada_b = nrm(ks[4], (L, 6 * D), 0.02)
    w_in = nrm(ks[5], (L, D, IN_COLS), D ** -0.5)
    q_norm_g = 1.0 + nrm(ks[6], (L, MLA_Q_RANK), 0.02)
    kv_norm_g = 1.0 + nrm(ks[7], (L, MLA_KV_RANK), 0.02)
    w_uq = nrm(ks[8], (L, MLA_Q_RANK, MLA_HEADS * (MLA_NOPE + MLA_ROPE)), MLA_Q_RANK ** -0.5)
    w_ukv = nrm(ks[9], (L, MLA_KV_RANK, MLA_HEADS * (MLA_NOPE + MLA_V)), MLA_KV_RANK ** -0.5)
    conv_w = nrm(ks[10], (L, CONV_WIDTH, CONV_CH), CONV_WIDTH ** -0.5)
    w_o = nrm(ks[11], (L, D_MIX, D), DEEPNORM_BETA * D_MIX ** -0.5)
    ln1_g = 1.0 + nrm(ks[12], (L, D), 0.02)
    ln1_b = nrm(ks[13], (L, D), 0.02)
    peer_wq = nrm(ks[14], (L, D, PEER_HEADS * PEER_D_KEY), D ** -0.5)
    peer_k1 = nrm(ks[15], (L, PEER_HEADS, PEER_N_KEYS, PEER_HALF), PEER_HALF ** -0.5)
    peer_k2 = nrm(ks[16], (L, PEER_HEADS, PEER_N_KEYS, PEER_HALF), PEER_HALF ** -0.5)
    peer_u = nrm(ks[17], (L, PEER_N_EXPERTS, D), D ** -0.5)
    peer_v = nrm(ks[18], (L, PEER_N_EXPERTS, D), DEEPNORM_BETA * PEER_HEADS ** -0.5)
    ln2_g = 1.0 + nrm(ks[19], (L, D), 0.02)
    ln2_b = nrm(ks[20], (L, D), 0.02)
    return {"x": x, "c": c, "positions": positions, "ada_w": ada_w, "ada_b": ada_b,
            "w_in": w_in, "q_norm_g": q_norm_g, "kv_norm_g": kv_norm_g, "w_uq": w_uq,
            "w_ukv": w_ukv, "conv_w": conv_w, "w_o": w_o, "ln1_g": ln1_g, "ln1_b": ln1_b,
            "peer_wq": peer_wq, "peer_k1": peer_k1, "peer_k2": peer_k2, "peer_u": peer_u,
            "peer_v": peer_v, "ln2_g": ln2_g, "ln2_b": ln2_b}


def reference(x, c, positions, ada_w, ada_b, w_in, q_norm_g, kv_norm_g, w_uq, w_ukv, conv_w,
              w_o, ln1_g, ln1_b, peer_wq, peer_k1, peer_k2, peer_u, peer_v, ln2_g, ln2_b):
    c_act = jax.nn.silu(c)
    for l in range(DEPTH):
        mod = c_act @ ada_w[l] + ada_b[l]
        sh1, sc1, g1, sh2, sc2, g2 = jnp.split(mod, 6, axis=-1)
        h = _modulate(x, sh1, sc1)
        mix = _hybrid_mixer(h, positions, w_in[l], q_norm_g[l], kv_norm_g[l], w_uq[l], w_ukv[l],
                            conv_w[l], w_o[l])
        x = _layer_norm(DEEPNORM_ALPHA * x + (1.0 + g1)[:, None, :] * mix, ln1_g[l], ln1_b[l])
        h = _modulate(x, sh2, sc2)
        ffn = _peer(h, peer_wq[l], peer_k1[l], peer_k2[l], peer_u[l], peer_v[l])
        x = _layer_norm(DEEPNORM_ALPHA * x + (1.0 + g2)[:, None, :] * ffn, ln2_g[l], ln2_b[l])
    return x
```

```cpp
#include <hip/hip_runtime.h>
#include <hip/hip_cooperative_groups.h>
#include <cstdio>
#include <cstdint>

#define LAS __attribute__((address_space(3)))
typedef unsigned short bf16_t;
typedef short bf16x8 __attribute__((ext_vector_type(8)));
typedef float f32x4 __attribute__((ext_vector_type(4)));
typedef float f32x16 __attribute__((ext_vector_type(16)));
typedef unsigned u32x4 __attribute__((ext_vector_type(4)));
typedef unsigned u32x2 __attribute__((ext_vector_type(2)));

constexpr int D = 1024, NB = 16, SEQ = 2048, T = NB * SEQ, NL = 2;
constexpr int NPROJ = 2048;
constexpr int NEXP = 16384;
constexpr float LN_EPS = 1e-5f, RMS_EPS = 1e-6f;
constexpr float ALPHA = 1.4142135623730951f;
constexpr float LOG2E = 1.4426950408889634f;
constexpr float CQ = 0.10206207261596577f * LOG2E;
constexpr int PC_QLAT = 0, PC_KVLAT = 256, PC_CB = 384, PC_CC = 640, PC_CH = 896, PC_SBQ = 1152, PC_SBK = 1408, PC_SBV = 1664, PC_KROPE = 1920, PC_END = 1952;

constexpr size_t MiB = 1u << 20;
constexpr size_t WS_CTL = 0, CTL_BYTES = 1 * MiB;
constexpr size_t WS_SSQQ = 6 * MiB, WS_SSQKV = 7 * MiB;
constexpr size_t WS_MOD = 1 * MiB;
constexpr size_t WS_COS = 2 * MiB, WS_SIN = 4 * MiB;
constexpr size_t WS_WIN = 8 * MiB;
constexpr size_t WS_WO = 16 * MiB;
constexpr size_t WS_WQ = 20 * MiB;
constexpr size_t WS_WUQ = 28 * MiB;
constexpr size_t WS_WUKV = 29 * MiB;
constexpr size_t WS_K1 = 30 * MiB, WS_K2 = 30 * MiB + 512 * 1024;
constexpr size_t WS_IDX = 32 * MiB, WS_QLAT = 32 * MiB;
constexpr size_t WS_GATE = 48 * MiB, WS_KVLAT = 48 * MiB;
constexpr size_t WS_H1 = 64 * MiB, WS_CONCAT = 64 * MiB;
constexpr size_t WS_H2 = 128 * MiB;
constexpr size_t WS_PROJ = 192 * MiB, WS_PQ = 192 * MiB;
constexpr size_t WS_X2 = 320 * MiB;
constexpr size_t WS_UB = 448 * MiB, WS_VB = 480 * MiB;
constexpr size_t WS_END = 512 * MiB;
constexpr size_t OUT_Q = 0, OUT_K = 48 * MiB, OUT_V = 96 * MiB;

constexpr int LDS_BYTES = 147456;
constexpr int NTHR = 512;

struct Params {
    const float *x, *c; const int* pos;
    const float *ada_w, *ada_b, *w_in, *qg, *kvg, *w_uq, *w_ukv, *conv_w, *w_o, *ln1_g, *ln1_b, *wq, *k1, *k2, *pu, *pv, *ln2_g, *ln2_b;
    float* out; unsigned char* ws;
};

__device__ __forceinline__ unsigned f2bf(float f) { unsigned u = __builtin_bit_cast(unsigned, f); return (u + 0x7fffu + ((u >> 16) & 1u)) >> 16; }
__device__ __forceinline__ unsigned pk2(float lo, float hi) { return f2bf(lo) | (f2bf(hi) << 16); }
__device__ __forceinline__ float bf_lo(unsigned u) { return __builtin_bit_cast(float, u << 16); }
__device__ __forceinline__ float bf_hi(unsigned u) { return __builtin_bit_cast(float, u & 0xffff0000u); }
__device__ __forceinline__ float bf2f(bf16_t h) { return __builtin_bit_cast(float, (unsigned)h << 16); }
__device__ __forceinline__ float wave_sum(float v) {
#pragma unroll
    for (int o = 1; o < 64; o <<= 1) v += __shfl_xor(v, o);
    return v;
}
__device__ __forceinline__ float wave_max(float v) {
#pragma unroll
    for (int o = 1; o < 64; o <<= 1) v = fmaxf(v, __shfl_xor(v, o));
    return v;
}
__device__ __forceinline__ float vmaxf(float a, float b) { float r; asm("v_max_f32 %0, %1, %2" : "=v"(r) : "v"(a), "v"(b)); return r; }
__device__ __forceinline__ float vminf(float a, float b) { float r; asm("v_min_f32 %0, %1, %2" : "=v"(r) : "v"(a), "v"(b)); return r; }

__device__ __forceinline__ void transpose_item(const float* W, int ldw, int K, bf16_t* WT, int n_src0, int n_dst0, int k0, const float* kscale, bool zero, LAS float* scr, int lane) {
    if (!zero) {
#pragma unroll 8
        for (int i = 0; i < 32; ++i) { const int kk = 2 * i + (lane >> 5); float v = W[(size_t)(k0 + kk) * ldw + n_src0 + (lane & 31)]; if (kscale) v *= kscale[k0 + kk]; scr[kk * 33 + (lane & 31)] = v; }
    }
    asm volatile("s_waitcnt lgkmcnt(0)" ::: "memory");
    const int c = lane & 7;
#pragma unroll
    for (int j = 0; j < 4; ++j) {
        const int n = (lane >> 3) + 8 * j; const LAS float* s = scr + (8 * c) * 33 + n;
        u32x4 o;
        if (zero) { o = (u32x4){0u, 0u, 0u, 0u}; }
        else { o.x = pk2(s[0 * 33], s[1 * 33]); o.y = pk2(s[2 * 33], s[3 * 33]); o.z = pk2(s[4 * 33], s[5 * 33]); o.w = pk2(s[6 * 33], s[7 * 33]); }
        *(u32x4*)(WT + (size_t)(n_dst0 + n) * K + k0 + 8 * c) = o;
    }
    asm volatile("s_waitcnt lgkmcnt(0)" ::: "memory");
}

__device__ __forceinline__ int proj_src_col(int n) {
    if (n < 384) return n;
    if (n < 1920) return n + 32;
    if (n < 1952) return n - 1920 + 384;
    return -1;
}

__device__ void phase_prep_weights(const Params& p, LAS unsigned char* lds, int bid, int nb) {
    const int tid = threadIdx.x, lane = tid & 63, wave = tid >> 6;
    LAS float* scr = (LAS float*)(lds + wave * 16384);
    const int gw = bid * 8 + wave, ngw = nb * 8;
    constexpr int I_WIN = 16 * 64, I_WO = 16 * 32, I_WQ = 16 * 64, I_UQ = 4 * 24, I_UKV = 2 * 32;
    constexpr int I_L = I_WIN + I_WO + I_WQ + I_UQ + I_UKV;
    for (int it = gw; it < NL * I_L; it += ngw) {
        const int l = it / I_L; int r = it % I_L;
        if (r < I_WIN) { const int kb = r / 64, nbk = r % 64, n0 = nbk * 32, src = proj_src_col(n0);
            transpose_item(p.w_in + (size_t)l * D * PC_END, PC_END, D, (bf16_t*)(p.ws + WS_WIN) + (size_t)l * NPROJ * D, src < 0 ? 0 : src, n0, kb * 64, nullptr, src < 0, scr, lane); continue; }
        r -= I_WIN;
        if (r < I_WO) { const int kb = r / 32, nbk = r % 32;
            transpose_item(p.w_o + (size_t)l * D * D, D, D, (bf16_t*)(p.ws + WS_WO) + (size_t)l * D * D, nbk * 32, nbk * 32, kb * 64, nullptr, false, scr, lane); continue; }
        r -= I_WO;
        if (r < I_WQ) { const int kb = r / 64, nbk = r % 64;
            transpose_item(p.wq + (size_t)l * D * 2048, 2048, D, (bf16_t*)(p.ws + WS_WQ) + (size_t)l * 2048 * D, nbk * 32, nbk * 32, kb * 64, nullptr, false, scr, lane); continue; }
        r -= I_WQ;
        if (r < I_UQ) { const int kb = r / 24, nbk = r % 24;
            transpose_item(p.w_uq + (size_t)l * 256 * 768, 768, 256, (bf16_t*)(p.ws + WS_WUQ) + (size_t)l * 768 * 256, nbk * 32, nbk * 32, kb * 64, p.qg + l * 256, false, scr, lane); continue; }
        r -= I_UQ;
        { const int kb = r / 32, nbk = r % 32;
            transpose_item(p.w_ukv + (size_t)l * 128 * 1024, 1024, 128, (bf16_t*)(p.ws + WS_WUKV) + (size_t)l * 1024 * 128, nbk * 32, nbk * 32, kb * 64, p.kvg + l * 128, false, scr, lane); }
    }
    const int gt = bid * NTHR + tid, ngt = nb * NTHR;
    bf16_t* k1b = (bf16_t*)(p.ws + WS_K1); bf16_t* k2b = (bf16_t*)(p.ws + WS_K2);
    for (int i = gt; i < NL * 8 * 128 * 128; i += ngt) { k1b[i] = (bf16_t)f2bf(p.k1[i]); k2b[i] = (bf16_t)f2bf(p.k2[i]); }
    float* cosT = (float*)(p.ws + WS_COS); float* sinT = (float*)(p.ws + WS_SIN);
    for (int i = gt; i < T * 16; i += ngt) {
        const int t = i >> 4, j = i & 15;
        const float inv = powf(10000.0f, -(float)j / 16.0f);
        const float ang = (float)p.pos[t] * inv;
        cosT[i] = cosf(ang); sinT[i] = sinf(ang);
    }
}

__device__ void phase_prep_tables(const Params& p, int l, int bid, int nb) {
    const int gt = bid * NTHR + threadIdx.x, ngt = nb * NTHR;
    const f32x4* su = (const f32x4*)(p.pu + (size_t)l * NEXP * D); const f32x4* sv = (const f32x4*)(p.pv + (size_t)l * NEXP * D);
    u32x4* du = (u32x4*)(p.ws + WS_UB); u32x4* dv = (u32x4*)(p.ws + WS_VB);
    for (int i = gt; i < NEXP * D / 8; i += ngt) {
        const f32x4 a = su[2 * i], b = su[2 * i + 1]; du[i] = (u32x4){pk2(a.x, a.y), pk2(a.z, a.w), pk2(b.x, b.y), pk2(b.z, b.w)};
        const f32x4 c = sv[2 * i], d = sv[2 * i + 1]; dv[i] = (u32x4){pk2(c.x, c.y), pk2(c.z, c.w), pk2(d.x, d.y), pk2(d.z, d.w)};
    }
}

__device__ void phase_mod(const Params& p, LAS unsigned char* lds, int bid, int nb) {
    const int tid = threadIdx.x, lane = tid & 63, wave = tid >> 6;
    LAS float* cact = (LAS float*)lds;
    LAS float* part = (LAS float*)(lds + 65536);
    if (bid >= NL * 96) return;
    for (int i = tid; i < NB * D; i += NTHR) { const float v = p.c[i]; cact[i] = v / (1.0f + expf(-v)); }
    __syncthreads();
    float* mod = (float*)(p.ws + WS_MOD);
    for (int item = bid; item < NL * 96; item += nb) {
        const int l = item / 96, col0 = (item % 96) * 64;
        const float* W = p.ada_w + (size_t)l * D * 6144 + col0 + lane;
        float acc[16];
#pragma unroll
        for (int b = 0; b < 16; ++b) acc[b] = 0.f;
#pragma unroll 4
        for (int k = wave * 128; k < wave * 128 + 128; ++k) {
            const float wv = W[(size_t)k * 6144];
#pragma unroll
            for (int b = 0; b < 16; ++b) acc[b] += cact[b * 1024 + k] * wv;
        }
#pragma unroll
        for (int b = 0; b < 16; ++b) part[(wave * 16 + b) * 64 + lane] = acc[b];
        __syncthreads();
        for (int o = tid; o < 1024; o += NTHR) {
            const int b = o >> 6, cl = o & 63; float s = p.ada_b[l * 6144 + col0 + cl];
#pragma unroll
            for (int w = 0; w < 8; ++w) s += part[(w * 16 + b) * 64 + cl];
            mod[((size_t)l * 16 + b) * 6144 + col0 + cl] = s;
        }
        __syncthreads();
    }
}

struct Row16 { float v[16]; };
__device__ __forceinline__ void row_load_f32(const float* row, int lane, float (&v)[16]) {
    const f32x4 a = *(const f32x4*)(row + 8 * lane), b = *(const f32x4*)(row + 8 * lane + 4), c = *(const f32x4*)(row + 512 + 8 * lane), d = *(const f32x4*)(row + 512 + 8 * lane + 4);
    v[0] = a.x; v[1] = a.y; v[2] = a.z; v[3] = a.w; v[4] = b.x; v[5] = b.y; v[6] = b.z; v[7] = b.w;
    v[8] = c.x; v[9] = c.y; v[10] = c.z; v[11] = c.w; v[12] = d.x; v[13] = d.y; v[14] = d.z; v[15] = d.w;
}
__device__ __forceinline__ void row_store_f32(float* row, int lane, const float (&v)[16]) {
    *(f32x4*)(row + 8 * lane) = (f32x4){v[0], v[1], v[2], v[3]}; *(f32x4*)(row + 8 * lane + 4) = (f32x4){v[4], v[5], v[6], v[7]};
    *(f32x4*)(row + 512 + 8 * lane) = (f32x4){v[8], v[9], v[10], v[11]}; *(f32x4*)(row + 512 + 8 * lane + 4) = (f32x4){v[12], v[13], v[14], v[15]};
}
__device__ __forceinline__ void row_store_bf16(bf16_t* row, int lane, const float (&v)[16]) {
    *(u32x4*)(row + 8 * lane) = (u32x4){pk2(v[0], v[1]), pk2(v[2], v[3]), pk2(v[4], v[5]), pk2(v[6], v[7])};
    *(u32x4*)(row + 512 + 8 * lane) = (u32x4){pk2(v[8], v[9]), pk2(v[10], v[11]), pk2(v[12], v[13]), pk2(v[14], v[15])};
}
__device__ __forceinline__ void row_normalize(float (&v)[16]) {
    float s = 0.f;
#pragma unroll
    for (int i = 0; i < 16; ++i) s += v[i];
    const float mean = wave_sum(s) * (1.0f / D);
    float q = 0.f;
#pragma unroll
    for (int i = 0; i < 16; ++i) { v[i] -= mean; q += v[i] * v[i]; }
    const float rstd = 1.0f / sqrtf(wave_sum(q) * (1.0f / D) + LN_EPS);
#pragma unroll
    for (int i = 0; i < 16; ++i) v[i] *= rstd;
}
__device__ __forceinline__ void row_modulate(float (&v)[16], const float* shift, const float* scale, int lane) {
    float sh[16], sc[16]; row_load_f32(shift, lane, sh); row_load_f32(scale, lane, sc);
#pragma unroll
    for (int i = 0; i < 16; ++i) v[i] = v[i] * (1.0f + sc[i]) + sh[i];
}
__device__ __forceinline__ void row_affine(float (&v)[16], const float* g, const float* b, int lane) {
    float gg[16], bb[16]; row_load_f32(g, lane, gg); row_load_f32(b, lane, bb);
#pragma unroll
    for (int i = 0; i < 16; ++i) v[i] = v[i] * gg[i] + bb[i];
}

__device__ void phase_rowA(const Params& p, int l, const float* xin, int bid, int nb) {
    const int lane = threadIdx.x & 63, gw = bid * 8 + (threadIdx.x >> 6), ngw = nb * 8;
    const float* mod = (const float*)(p.ws + WS_MOD) + (size_t)l * 16 * 6144;
    bf16_t* H1 = (bf16_t*)(p.ws + WS_H1);
    for (int t = gw; t < T; t += ngw) {
        float v[16]; row_load_f32(xin + (size_t)t * D, lane, v);
        row_normalize(v);
        const float* m = mod + (size_t)(t / SEQ) * 6144;
        row_modulate(v, m + 0, m + 1024, lane);
        row_store_bf16(H1 + (size_t)t * D, lane, v);
    }
}
__device__ void phase_rowF(const Params& p, int l, int bid, int nb) {
    const int lane = threadIdx.x & 63, gw = bid * 8 + (threadIdx.x >> 6), ngw = nb * 8;
    const float* mod = (const float*)(p.ws + WS_MOD) + (size_t)l * 16 * 6144;
    bf16_t* H2 = (bf16_t*)(p.ws + WS_H2);
    float* Y = p.out;
    for (int t = gw; t < T; t += ngw) {
        float v[16]; row_load_f32(Y + (size_t)t * D, lane, v);
        row_normalize(v);
        row_affine(v, p.ln1_g + l * D, p.ln1_b + l * D, lane);
        row_store_f32(Y + (size_t)t * D, lane, v);
        row_normalize(v);
        const float* m = mod + (size_t)(t / SEQ) * 6144;
        row_modulate(v, m + 3072, m + 4096, lane);
        row_store_bf16(H2 + (size_t)t * D, lane, v);
    }
}

template <class Epi>
__device__ void gemm_simple(const bf16_t* A, int lda, const bf16_t* Bt, int ldb, int M, int N, int K, const Epi& epi, int bid, int nb) {
    const int tid = threadIdx.x, lane = tid & 63, wave = tid >> 6, fr = lane & 15, fq = lane >> 4, wm = wave & 3, wn = wave >> 2;
    const int tn = N / 128, ntile = (M / 128) * tn;
    for (int tile = bid; tile < ntile; tile += nb) {
        const int row0 = (tile / tn) * 128 + wm * 32, col0 = (tile % tn) * 128 + wn * 64;
        f32x4 acc[2][4];
#pragma unroll
        for (int mi = 0; mi < 2; ++mi)
#pragma unroll
            for (int ni = 0; ni < 4; ++ni) acc[mi][ni] = (f32x4){0.f, 0.f, 0.f, 0.f};
        const bf16_t* ap = A + (size_t)(row0 + fr) * lda + fq * 8;
        const bf16_t* bp = Bt + (size_t)(col0 + fr) * ldb + fq * 8;
#pragma unroll 2
        for (int k0 = 0; k0 < K; k0 += 32) {
            bf16x8 a[2], b[4];
#pragma unroll
            for (int mi = 0; mi < 2; ++mi) a[mi] = *(const bf16x8*)(ap + (size_t)mi * 16 * lda + k0);
#pragma unroll
            for (int ni = 0; ni < 4; ++ni) b[ni] = *(const bf16x8*)(bp + (size_t)ni * 16 * ldb + k0);
#pragma unroll
            for (int mi = 0; mi < 2; ++mi)
#pragma unroll
                for (int ni = 0; ni < 4; ++ni) acc[mi][ni] = __builtin_amdgcn_mfma_f32_16x16x32_bf16(b[ni], a[mi], acc[mi][ni], 0, 0, 0);
        }
#pragma unroll
        for (int mi = 0; mi < 2; ++mi)
#pragma unroll
            for (int np = 0; np < 2; ++np) epi(row0 + mi * 16 + fr, col0 + np * 32 + 4 * fq, acc[mi][2 * np], acc[mi][2 * np + 1]);
    }
}

__device__ __forceinline__ void store_bf16x4(bf16_t* p, f32x4 v) { *(u32x2*)p = (u32x2){pk2(v.x, v.y), pk2(v.z, v.w)}; }

struct EpiProj {
    bf16_t *proj, *qlat, *kvlat; float *ssq_q, *ssq_kv;
    __device__ __forceinline__ void operator()(int row, int col, f32x4 v0, f32x4 v1) const {
        const int cb = col & ~31;
        if (cb < 256) { store_bf16x4(qlat + (size_t)row * 256 + col, v0); store_bf16x4(qlat + (size_t)row * 256 + col + 16, v1); }
        else if (cb < 384) { store_bf16x4(kvlat + (size_t)row * 128 + col - 256, v0); store_bf16x4(kvlat + (size_t)row * 128 + col - 256 + 16, v1); }
        else { store_bf16x4(proj + (size_t)row * NPROJ + col, v0); store_bf16x4(proj + (size_t)row * NPROJ + col + 16, v1); }
        if (cb < 384) {
            float s = v0.x * v0.x + v0.y * v0.y + v0.z * v0.z + v0.w * v0.w + v1.x * v1.x + v1.y * v1.y + v1.z * v1.z + v1.w * v1.w;
            s += __shfl_xor(s, 16); s += __shfl_xor(s, 32);
            if ((threadIdx.x & 63) < 16) { if (cb < 256) ssq_q[(size_t)row * 8 + (cb >> 5)] = s; else ssq_kv[(size_t)row * 4 + ((cb - 256) >> 5)] = s; }
        }
    }
};
struct EpiQ {
    bf16_t* q; const float *ssq, *cosT, *sinT;
    __device__ __forceinline__ void operator()(int row, int col, f32x4 v0, f32x4 v1) const {
        const f32x4 sa = *(const f32x4*)(ssq + (size_t)row * 8), sb = *(const f32x4*)(ssq + (size_t)row * 8 + 4);
        const float rs = CQ / sqrtf((((sa.x + sa.y) + (sa.z + sa.w)) + ((sb.x + sb.y) + (sb.z + sb.w))) * (1.0f / 256.0f) + RMS_EPS);
        v0 *= rs; v1 *= rs;
        const int cb = col >> 5;
        if (cb % 3 == 2) {
            const int i0 = col & 31;
            const f32x4 cs = *(const f32x4*)(cosT + (size_t)row * 16 + i0), sn = *(const f32x4*)(sinT + (size_t)row * 16 + i0);
            const f32x4 a = v0 * cs - v1 * sn, b = v1 * cs + v0 * sn; v0 = a; v1 = b;
        }
        store_bf16x4(q + (size_t)row * 768 + col, v0); store_bf16x4(q + (size_t)row * 768 + col + 16, v1);
    }
};
struct EpiKV {
    bf16_t *k, *v; const float* ssq;
    __device__ __forceinline__ void operator()(int row, int col, f32x4 v0, f32x4 v1) const {
        const f32x4 sa = *(const f32x4*)(ssq + (size_t)row * 4);
        const float rs = 1.0f / sqrtf(((sa.x + sa.y) + (sa.z + sa.w)) * (1.0f / 128.0f) + RMS_EPS);
        v0 *= rs; v1 *= rs;
        const int h = col >> 7, j = col & 127;
        if (j < 64) { store_bf16x4(k + (size_t)row * 768 + h * 96 + j, v0); store_bf16x4(k + (size_t)row * 768 + h * 96 + j + 16, v1); }
        else { store_bf16x4(v + (size_t)row * 512 + h * 64 + j - 64, v0); store_bf16x4(v + (size_t)row * 512 + h * 64 + j - 64 + 16, v1); }
    }
};
struct EpiY {
    float* y; const float* xin; const float* gate;
    __device__ __forceinline__ void operator()(int row, int col, f32x4 v0, f32x4 v1) const {
        const float* g = gate + (size_t)(row / SEQ) * 6144 + col; const float* xr = xin + (size_t)row * D + col; float* yr = y + (size_t)row * D + col;
        const f32x4 g0 = *(const f32x4*)g, g1 = *(const f32x4*)(g + 16), x0 = *(const f32x4*)xr, x1 = *(const f32x4*)(xr + 16);
        *(f32x4*)yr = ALPHA * x0 + (1.0f + g0) * v0; *(f32x4*)(yr + 16) = ALPHA * x1 + (1.0f + g1) * v1;
    }
};
struct EpiBf {
    bf16_t* o; int ldc;
    __device__ __forceinline__ void operator()(int row, int col, f32x4 v0, f32x4 v1) const { store_bf16x4(o + (size_t)row * ldc + col, v0); store_bf16x4(o + (size_t)row * ldc + col + 16, v1); }
};

__device__ void phase_conv_krope(const Params& p, int l, int bid, int nb) {
    const int lane = threadIdx.x & 63, gw = bid * 8 + (threadIdx.x >> 6), ngw = nb * 8;
    const bf16_t* proj = (const bf16_t*)(p.ws + WS_PROJ); bf16_t* cc = (bf16_t*)(p.ws + WS_CONCAT); bf16_t* K = (bf16_t*)((unsigned char*)p.out + OUT_K);
    const float* cosT = (const float*)(p.ws + WS_COS); const float* sinT = (const float*)(p.ws + WS_SIN);
    const float* cw = p.conv_w + (size_t)l * 3 * 256;
    for (int t = gw; t < T; t += ngw) {
        const int s = t % SEQ, c0 = 4 * lane;
        float y[4] = {0.f, 0.f, 0.f, 0.f};
#pragma unroll
        for (int tap = 0; tap < 3; ++tap) {
            const int ds = 2 - tap;
            if (s - ds >= 0) {
                const u32x2 a = *(const u32x2*)(proj + (size_t)(t - ds) * NPROJ + PC_CC + c0), b = *(const u32x2*)(proj + (size_t)(t - ds) * NPROJ + PC_CH + c0);
                const f32x4 w = *(const f32x4*)(cw + tap * 256 + c0);
                y[0] += w.x * (bf_lo(a.x) * bf_lo(b.x)); y[1] += w.y * (bf_hi(a.x) * bf_hi(b.x)); y[2] += w.z * (bf_lo(a.y) * bf_lo(b.y)); y[3] += w.w * (bf_hi(a.y) * bf_hi(b.y));
            }
        }
        const u32x2 gb = *(const u32x2*)(proj + (size_t)t * NPROJ + PC_CB + c0);
        *(u32x2*)(cc + (size_t)t * D + 512 + c0) = (u32x2){pk2(bf_lo(gb.x) * y[0], bf_hi(gb.x) * y[1]), pk2(bf_lo(gb.y) * y[2], bf_hi(gb.y) * y[3])};
        const int i = lane & 15, half = (lane >> 4) & 1, hg = lane >> 5;
        const float x1 = bf2f(proj[(size_t)t * NPROJ + PC_KROPE + i]), x2 = bf2f(proj[(size_t)t * NPROJ + PC_KROPE + 16 + i]);
        const float cs = cosT[(size_t)t * 16 + i], sn = sinT[(size_t)t * 16 + i];
        const bf16_t o = (bf16_t)f2bf(half ? (x2 * cs + x1 * sn) : (x1 * cs - x2 * sn));
#pragma unroll
        for (int hh = 0; hh < 4; ++hh) K[(size_t)t * 768 + (hg * 4 + hh) * 96 + 64 + half * 16 + i] = o;
    }
}

__global__ void __launch_bounds__(256) k_mla_naive(Params p) {
    __shared__ float sc[4][2048];
    __shared__ float qs[4][96];
    const int lane = threadIdx.x & 63, w = threadIdx.x >> 6;
    const bf16_t* Q = (const bf16_t*)((unsigned char*)p.out + OUT_Q); const bf16_t* K = (const bf16_t*)((unsigned char*)p.out + OUT_K); const bf16_t* V = (const bf16_t*)((unsigned char*)p.out + OUT_V);
    bf16_t* cc = (bf16_t*)(p.ws + WS_CONCAT);
    for (int item = blockIdx.x * 4 + w; item < T * 8; item += gridDim.x * 4) {
        const int t = item >> 3, h = item & 7, b = t / SEQ, s = t % SEQ, kvlen = (s / 64 + 1) * 64;
        qs[w][lane] = bf2f(Q[(size_t)t * 768 + h * 96 + lane]); if (lane < 32) qs[w][64 + lane] = bf2f(Q[(size_t)t * 768 + h * 96 + 64 + lane]);
        __builtin_amdgcn_wave_barrier();
        float m = -3.0e38f;
        for (int j = lane; j < kvlen; j += 64) {
            const bf16_t* kr = K + (size_t)(b * SEQ + j) * 768 + h * 96; float d = 0.f;
            for (int c = 0; c < 12; ++c) { const u32x4 kk = *(const u32x4*)(kr + 8 * c);
                d += qs[w][8 * c + 0] * bf_lo(kk.x) + qs[w][8 * c + 1] * bf_hi(kk.x) + qs[w][8 * c + 2] * bf_lo(kk.y) + qs[w][8 * c + 3] * bf_hi(kk.y)
                   + qs[w][8 * c + 4] * bf_lo(kk.z) + qs[w][8 * c + 5] * bf_hi(kk.z) + qs[w][8 * c + 6] * bf_lo(kk.w) + qs[w][8 * c + 7] * bf_hi(kk.w); }
            sc[w][j] = d; m = fmaxf(m, d);
        }
        m = wave_max(m);
        float lsum = 0.f;
        for (int j = lane; j < kvlen; j += 64) { const float e = exp2f(sc[w][j] - m); sc[w][j] = e; lsum += e; }
        lsum = wave_sum(lsum);
        __builtin_amdgcn_wave_barrier();
        float o = 0.f;
        const bf16_t* vb = V + (size_t)(b * SEQ) * 512 + h * 64 + lane;
        for (int j = 0; j < kvlen; ++j) o += sc[w][j] * bf2f(vb[(size_t)j * 512]);
        cc[(size_t)t * D + h * 64 + lane] = (bf16_t)f2bf(o / lsum);
        __builtin_amdgcn_wave_barrier();
    }
}
__global__ void __launch_bounds__(128) k_sb_naive(Params p) {
    __shared__ float wls[2][2048];
    __shared__ float wlom[2][2048];
    __shared__ float qs[2][64];
    const int lane = threadIdx.x & 63, w = threadIdx.x >> 6;
    const bf16_t* proj = (const bf16_t*)(p.ws + WS_PROJ); bf16_t* cc = (bf16_t*)(p.ws + WS_CONCAT);
    for (int item = blockIdx.x * 2 + w; item < T * 4; item += gridDim.x * 2) {
        const int t = item >> 2, h = item & 3, b = t / SEQ, s = t % SEQ;
        qs[w][lane] = bf2f(proj[(size_t)t * NPROJ + PC_SBQ + h * 64 + lane]);
        __builtin_amdgcn_wave_barrier();
        for (int j = lane; j < s; j += 64) {
            const bf16_t* kr = proj + (size_t)(b * SEQ + j) * NPROJ + PC_SBK + h * 64; float d = 0.f;
            for (int c = 0; c < 8; ++c) { const u32x4 kk = *(const u32x4*)(kr + 8 * c);
                d += qs[w][8 * c + 0] * bf_lo(kk.x) + qs[w][8 * c + 1] * bf_hi(kk.x) + qs[w][8 * c + 2] * bf_lo(kk.y) + qs[w][8 * c + 3] * bf_hi(kk.y)
                   + qs[w][8 * c + 4] * bf_lo(kk.z) + qs[w][8 * c + 5] * bf_hi(kk.z) + qs[w][8 * c + 6] * bf_lo(kk.w) + qs[w][8 * c + 7] * bf_hi(kk.w); }
            const float z = d * 0.125f;
            const float ls = fminf(z, 0.f) - log1pf(expf(-fabsf(z)));
            wls[w][j] = ls; wlom[w][j] = ls - z;
        }
        __builtin_amdgcn_wave_barrier();
        float carry = 0.f;
        for (int c0 = ((s + 63) / 64 - 1) * 64; c0 >= 0; c0 -= 64) {
            const int j = c0 + lane; const float xv = (j < s) ? wlom[w][j] : 0.f;
            float y = xv;
#pragma unroll
            for (int off = 1; off < 64; off <<= 1) { const float u = __shfl_down(y, off); if (lane + off < 64) y += u; }
            const float after = carry + y - xv;
            if (j < s) wls[w][j] = expf(wls[w][j] + after);
            carry += __shfl(y, 0);
        }
        __builtin_amdgcn_wave_barrier();
        float o = 0.f;
        const bf16_t* vb = proj + (size_t)(b * SEQ) * NPROJ + PC_SBV + h * 64 + lane;
        for (int j = 0; j < s; ++j) o += wls[w][j] * bf2f(vb[(size_t)j * NPROJ]);
        cc[(size_t)t * D + 768 + h * 64 + lane] = (bf16_t)f2bf(o);
        __builtin_amdgcn_wave_barrier();
    }
}

__device__ __forceinline__ void ins16(float (&L)[16], float x) {
#pragma unroll
    for (int i = 0; i < 16; ++i) { const float hi = vmaxf(L[i], x); x = vminf(L[i], x); L[i] = hi; }
}
__device__ void phase_topk(const Params& p, int l, LAS unsigned char* lds, int bid, int nb) {
    const int tid = threadIdx.x, lane = tid & 63, wave = tid >> 6, r32 = lane & 31, hi = lane >> 5;
    LAS float* LV = (LAS float*)lds;
    const bf16_t* PQ = (const bf16_t*)(p.ws + WS_PQ);
    const bf16_t* KB[2] = {(const bf16_t*)(p.ws + WS_K1) + (size_t)l * 8 * 128 * 128, (const bf16_t*)(p.ws + WS_K2) + (size_t)l * 8 * 128 * 128};
    int* IDX = (int*)(p.ws + WS_IDX); float* GATE = (float*)(p.ws + WS_GATE);
    for (int item = bid; item < (T / 128) * 2; item += nb) {
        const int tt = item >> 1, hg = item & 1;
        for (int task = wave; task < 32; task += 8) {
            const int st = task & 3, half = (task >> 2) & 1, hh = task >> 3, head = hg * 4 + hh;
            const bf16_t* qrow = PQ + (size_t)(tt * 128 + st * 32 + r32) * 2048 + head * 256 + half * 128 + hi * 8;
            bf16x8 qf[8];
#pragma unroll
            for (int s = 0; s < 8; ++s) qf[s] = *(const bf16x8*)(qrow + 16 * s);
            const bf16_t* kbase = KB[half] + (size_t)head * 128 * 128 + (size_t)r32 * 128 + hi * 8;
            float Lst[16];
#pragma unroll
            for (int i = 0; i < 16; ++i) Lst[i] = -3.0e38f;
#pragma unroll
            for (int kb = 0; kb < 4; ++kb) {
                f32x16 acc = {0.f, 0.f, 0.f, 0.f, 0.f, 0.f, 0.f, 0.f, 0.f, 0.f, 0.f, 0.f, 0.f, 0.f, 0.f, 0.f};
#pragma unroll
                for (int s = 0; s < 8; ++s) { const bf16x8 kf = *(const bf16x8*)(kbase + (size_t)kb * 32 * 128 + 16 * s); acc = __builtin_amdgcn_mfma_f32_32x32x16_bf16(kf, qf[s], acc, 0, 0, 0); }
#pragma unroll
                for (int r = 0; r < 16; ++r) {
                    const int key = kb * 32 + (r & 3) + 8 * (r >> 2) + 4 * hi;
                    const float av = acc[r];
                    const float x = __uint_as_float((__float_as_uint(av) & 0xffffff80u) | (unsigned)key);
                    ins16(Lst, x);
                }
            }
            float M[16];
#pragma unroll
            for (int i = 0; i < 16; ++i) { const float o = __shfl_xor(Lst[15 - i], 32); M[i] = vmaxf(Lst[i], o); }
#pragma unroll
            for (int dlt = 8; dlt >= 1; dlt >>= 1)
#pragma unroll
                for (int i = 0; i < 16; ++i) if ((i & dlt) == 0) { const float a = vmaxf(M[i], M[i + dlt]), b = vminf(M[i], M[i + dlt]); M[i] = a; M[i + dlt] = b; }
            if (hi == 0) {
                LAS float* dst = LV + ((size_t)((hh * 2 + half) * 128 + st * 32 + r32)) * 16;
#pragma unroll
                for (int i = 0; i < 16; i += 4) *(LAS f32x4*)(dst + i) = (f32x4){M[i], M[i + 1], M[i + 2], M[i + 3]};
            }
        }
        __syncthreads();
        {
            const int tok = tid & 127, hh = tid >> 7, head = hg * 4 + hh, t = tt * 128 + tok;
            const LAS float* a1 = LV + ((size_t)((hh * 2 + 0) * 128 + tok)) * 16; const LAS float* a2 = LV + ((size_t)((hh * 2 + 1) * 128 + tok)) * 16;
            float v1[16], v2[16];
#pragma unroll
            for (int i = 0; i < 16; i += 4) { const f32x4 x = *(const LAS f32x4*)(a1 + i), y = *(const LAS f32x4*)(a2 + i); v1[i] = x.x; v1[i + 1] = x.y; v1[i + 2] = x.z; v1[i + 3] = x.w; v2[i] = y.x; v2[i + 1] = y.y; v2[i + 2] = y.z; v2[i + 3] = y.w; }
            float Tt[16];
#pragma unroll
            for (int i = 0; i < 16; ++i) Tt[i] = -3.0e38f;
#pragma unroll
            for (int i = 0; i < 16; ++i)
#pragma unroll
                for (int j = 0; j < 16; ++j) if ((i + 1) * (j + 1) <= 16) {
                    const float sum = v1[i] + v2[j];
                    ins16(Tt, __builtin_bit_cast(float, (__builtin_bit_cast(unsigned, sum) & 0xffffff00u) | (unsigned)(i * 16 + j)));
                }
            float e[16], den = 0.f;
#pragma unroll
            for (int k = 0; k < 16; ++k) { e[k] = __expf(Tt[k] - Tt[0]); den += e[k]; }
            const float inv = 1.0f / den;
            int ex[16];
#pragma unroll
            for (int k = 0; k < 16; ++k) {
                const unsigned pos = __builtin_bit_cast(unsigned, Tt[k]) & 0xffu;
                const unsigned i1 = __builtin_bit_cast(unsigned, a1[pos >> 4]) & 0x7fu, i2 = __builtin_bit_cast(unsigned, a2[pos & 15]) & 0x7fu;
                ex[k] = (int)(i1 * 128u + i2);
            }
            int* ip = IDX + (size_t)t * 128 + head * 16; float* gp = GATE + (size_t)t * 128 + head * 16;
#pragma unroll
            for (int k = 0; k < 16; k += 4) { *(u32x4*)(ip + k) = (u32x4){(unsigned)ex[k], (unsigned)ex[k + 1], (unsigned)ex[k + 2], (unsigned)ex[k + 3]}; *(f32x4*)(gp + k) = (f32x4){e[k] * inv, e[k + 1] * inv, e[k + 2] * inv, e[k + 3] * inv}; }
        }
        __syncthreads();
    }
}

typedef __bf16 bf16x2_t __attribute__((ext_vector_type(2)));
__device__ __forceinline__ float dot2bf(unsigned a, unsigned b, float c) {
    return __builtin_amdgcn_fdot2_f32_bf16(__builtin_bit_cast(bf16x2_t, a), __builtin_bit_cast(bf16x2_t, b), c, false);
}
__device__ __forceinline__ float gelu_exact(float x) { return 0.5f * x * (1.0f + erff(x * 0.70710678118654752f)); }

__device__ void phase_experts(const Params& p, int l, bool last, int bid, int nb) {
    const int lane = threadIdx.x & 63, gw = bid * 8 + (threadIdx.x >> 6), ngw = nb * 8;
    const bf16_t* H2 = (const bf16_t*)(p.ws + WS_H2); const bf16_t* UB = (const bf16_t*)(p.ws + WS_UB); const bf16_t* VB = (const bf16_t*)(p.ws + WS_VB);
    const int* IDX = (const int*)(p.ws + WS_IDX); const float* GATE = (const float*)(p.ws + WS_GATE);
    const float* mod = (const float*)(p.ws + WS_MOD);
    const float* X1 = p.out; float* XO = last ? p.out : (float*)(p.ws + WS_X2); bf16_t* H1 = (bf16_t*)(p.ws + WS_H1);
    const int kl = ((lane >> 5) & 1) * 8 + ((lane >> 4) & 1) * 4 + ((lane >> 3) & 1) * 2 + ((lane >> 2) & 1);
    for (int t = gw; t < T; t += ngw) {
        const u32x4 h0 = *(const u32x4*)(H2 + (size_t)t * D + 8 * lane), h1 = *(const u32x4*)(H2 + (size_t)t * D + 512 + 8 * lane);
        const int idx0 = IDX[(size_t)t * 128 + lane], idx1 = IDX[(size_t)t * 128 + 64 + lane];
        float out[16];
#pragma unroll
        for (int i = 0; i < 16; ++i) out[i] = 0.f;
        for (int hd = 0; hd < 8; ++hd) {
            const int ireg = (hd < 4) ? idx0 : idx1; const int lbase = (hd & 3) * 16;
            float part[16];
#pragma unroll
            for (int k = 0; k < 16; ++k) {
                const int e = __builtin_amdgcn_readlane(ireg, lbase + k);
                const bf16_t* ur = UB + (size_t)e * D;
                const u32x4 u0 = *(const u32x4*)(ur + 8 * lane), u1 = *(const u32x4*)(ur + 512 + 8 * lane);
                float d = dot2bf(u0.x, h0.x, 0.f); d = dot2bf(u0.y, h0.y, d); d = dot2bf(u0.z, h0.z, d); d = dot2bf(u0.w, h0.w, d);
                d = dot2bf(u1.x, h1.x, d); d = dot2bf(u1.y, h1.y, d); d = dot2bf(u1.z, h1.z, d); d = dot2bf(u1.w, h1.w, d);
                part[k] = d;
            }
#pragma unroll
            for (int i = 0; i < 8; ++i) { const bool up = (lane & 32) != 0; const float keep = up ? part[i + 8] : part[i], give = up ? part[i] : part[i + 8]; part[i] = keep + __shfl_xor(give, 32); }
#pragma unroll
            for (int i = 0; i < 4; ++i) { const bool up = (lane & 16) != 0; const float keep = up ? part[i + 4] : part[i], give = up ? part[i] : part[i + 4]; part[i] = keep + __shfl_xor(give, 16); }
#pragma unroll
            for (int i = 0; i < 2; ++i) { const bool up = (lane & 8) != 0; const float keep = up ? part[i + 2] : part[i], give = up ? part[i] : part[i + 2]; part[i] = keep + __shfl_xor(give, 8); }
            { const bool up = (lane & 4) != 0; const float keep = up ? part[1] : part[0], give = up ? part[0] : part[1]; part[0] = keep + __shfl_xor(give, 4); }
            float dot = part[0]; dot += __shfl_xor(dot, 1); dot += __shfl_xor(dot, 2);
            const float coef = GATE[(size_t)t * 128 + hd * 16 + kl] * gelu_exact(dot);
#pragma unroll
            for (int k = 0; k < 16; ++k) {
                const int e = __builtin_amdgcn_readlane(ireg, lbase + k);
                const float ck = __builtin_bit_cast(float, __builtin_amdgcn_readlane(__builtin_bit_cast(int, coef), ((k >> 3) & 1) * 32 + ((k >> 2) & 1) * 16 + ((k >> 1) & 1) * 8 + (k & 1) * 4));
                const bf16_t* vr = VB + (size_t)e * D;
                const u32x4 a = *(const u32x4*)(vr + 8 * lane), b = *(const u32x4*)(vr + 512 + 8 * lane);
                out[0] += ck * bf_lo(a.x); out[1] += ck * bf_hi(a.x); out[2] += ck * bf_lo(a.y); out[3] += ck * bf_hi(a.y);
                out[4] += ck * bf_lo(a.z); out[5] += ck * bf_hi(a.z); out[6] += ck * bf_lo(a.w); out[7] += ck * bf_hi(a.w);
                out[8] += ck * bf_lo(b.x); out[9] += ck * bf_hi(b.x); out[10] += ck * bf_lo(b.y); out[11] += ck * bf_hi(b.y);
                out[12] += ck * bf_lo(b.z); out[13] += ck * bf_hi(b.z); out[14] += ck * bf_lo(b.w); out[15] += ck * bf_hi(b.w);
            }
        }
        const float* m = mod + ((size_t)l * 16 + t / SEQ) * 6144;
        float xv[16], g2[16]; row_load_f32(X1 + (size_t)t * D, lane, xv); row_load_f32(m + 5120, lane, g2);
#pragma unroll
        for (int i = 0; i < 16; ++i) xv[i] = ALPHA * xv[i] + (1.0f + g2[i]) * out[i];
        row_normalize(xv);
        row_affine(xv, p.ln2_g + l * D, p.ln2_b + l * D, lane);
        row_store_f32(XO + (size_t)t * D, lane, xv);
        if (!last) {
            row_normalize(xv);
            const float* mn = mod + ((size_t)(l + 1) * 16 + t / SEQ) * 6144;
            row_modulate(xv, mn + 0, mn + 1024, lane);
            row_store_bf16(H1 + (size_t)t * D, lane, xv);
        }
    }
}

extern __shared__ __attribute__((aligned(16))) unsigned char dyn_lds[];
#define LDSP ((LAS unsigned char*)dyn_lds)
__global__ void __launch_bounds__(NTHR, 2) k_prep(Params p) { phase_prep_weights(p, LDSP, blockIdx.x, gridDim.x); }
__global__ void __launch_bounds__(NTHR, 2) k_tables(Params p, int l) { phase_prep_tables(p, l, blockIdx.x, gridDim.x); }
__global__ void __launch_bounds__(NTHR, 2) k_mod(Params p) { phase_mod(p, LDSP, blockIdx.x, gridDim.x); }
__global__ void __launch_bounds__(NTHR, 2) k_rowA(Params p, int l) { phase_rowA(p, l, l == 0 ? p.x : (const float*)(p.ws + WS_X2), blockIdx.x, gridDim.x); }
__global__ void __launch_bounds__(NTHR, 2) k_rowF(Params p, int l) { phase_rowF(p, l, blockIdx.x, gridDim.x); }
__global__ void __launch_bounds__(NTHR, 2) k_gemmB(Params p, int l) {
    EpiProj e{(bf16_t*)(p.ws + WS_PROJ), (bf16_t*)(p.ws + WS_QLAT), (bf16_t*)(p.ws + WS_KVLAT), (float*)(p.ws + WS_SSQQ), (float*)(p.ws + WS_SSQKV)};
    gemm_simple((const bf16_t*)(p.ws + WS_H1), D, (const bf16_t*)(p.ws + WS_WIN) + (size_t)l * NPROJ * D, D, T, NPROJ, D, e, blockIdx.x, gridDim.x);
}
__global__ void __launch_bounds__(NTHR, 2) k_gemmC1(Params p, int l) {
    EpiQ e{(bf16_t*)((unsigned char*)p.out + OUT_Q), (const float*)(p.ws + WS_SSQQ), (const float*)(p.ws + WS_COS), (const float*)(p.ws + WS_SIN)};
    gemm_simple((const bf16_t*)(p.ws + WS_QLAT), 256, (const bf16_t*)(p.ws + WS_WUQ) + (size_t)l * 768 * 256, 256, T, 768, 256, e, blockIdx.x, gridDim.x);
}
__global__ void __launch_bounds__(NTHR, 2) k_gemmC2(Params p, int l) {
    EpiKV e{(bf16_t*)((unsigned char*)p.out + OUT_K), (bf16_t*)((unsigned char*)p.out + OUT_V), (const float*)(p.ws + WS_SSQKV)};
    gemm_simple((const bf16_t*)(p.ws + WS_KVLAT), 128, (const bf16_t*)(p.ws + WS_WUKV) + (size_t)l * 1024 * 128, 128, T, 1024, 128, e, blockIdx.x, gridDim.x);
}
__global__ void __launch_bounds__(NTHR, 2) k_convk(Params p, int l) { phase_conv_krope(p, l, blockIdx.x, gridDim.x); }
__global__ void __launch_bounds__(NTHR, 2) k_gemmE(Params p, int l) {
    EpiY e{p.out, l == 0 ? p.x : (const float*)(p.ws + WS_X2), (const float*)(p.ws + WS_MOD) + (size_t)l * 16 * 6144 + 2048};
    gemm_simple((const bf16_t*)(p.ws + WS_CONCAT), D, (const bf16_t*)(p.ws + WS_WO) + (size_t)l * D * D, D, T, D, D, e, blockIdx.x, gridDim.x);
}
__global__ void __launch_bounds__(NTHR, 2) k_gemmG(Params p, int l) {
    EpiBf e{(bf16_t*)(p.ws + WS_PQ), 2048};
    gemm_simple((const bf16_t*)(p.ws + WS_H2), D, (const bf16_t*)(p.ws + WS_WQ) + (size_t)l * 2048 * D, D, T, 2048, D, e, blockIdx.x, gridDim.x);
}
__global__ void __launch_bounds__(NTHR, 2) k_topk(Params p, int l) { phase_topk(p, l, LDSP, blockIdx.x, gridDim.x); }
__global__ void __launch_bounds__(NTHR, 2) k_experts(Params p, int l) { phase_experts(p, l, l == NL - 1, blockIdx.x, gridDim.x); }

extern "C" void kernel_launch(void* const* d_in, const int* in_sizes, int n_in, void* d_out, int out_size, void* d_ws, size_t ws_size, hipStream_t stream) {
    static int ok = 0;
    if (ok == 0) {
        ok = 1;
        if (n_in != 21 || out_size != T * D || ws_size < WS_END) { fprintf(stderr, "kernel_launch: unexpected shapes (n_in %d, out %d, ws %zu)\n", n_in, out_size, ws_size); ok = -1; }
        if (hipFuncSetAttribute((const void*)k_prep, hipFuncAttributeMaxDynamicSharedMemorySize, LDS_BYTES) != hipSuccess ||
            hipFuncSetAttribute((const void*)k_mod, hipFuncAttributeMaxDynamicSharedMemorySize, LDS_BYTES) != hipSuccess ||
            hipFuncSetAttribute((const void*)k_topk, hipFuncAttributeMaxDynamicSharedMemorySize, LDS_BYTES) != hipSuccess) { fprintf(stderr, "kernel_launch: hipFuncSetAttribute failed\n"); ok = -1; }
    }
    if (ok < 0) return;
    Params p{};
    p.x = (const float*)d_in[0]; p.c = (const float*)d_in[1]; p.pos = (const int*)d_in[2]; p.ada_w = (const float*)d_in[3]; p.ada_b = (const float*)d_in[4];
    p.w_in = (const float*)d_in[5]; p.qg = (const float*)d_in[6]; p.kvg = (const float*)d_in[7]; p.w_uq = (const float*)d_in[8]; p.w_ukv = (const float*)d_in[9];
    p.conv_w = (const float*)d_in[10]; p.w_o = (const float*)d_in[11]; p.ln1_g = (const float*)d_in[12]; p.ln1_b = (const float*)d_in[13]; p.wq = (const float*)d_in[14];
    p.k1 = (const float*)d_in[15]; p.k2 = (const float*)d_in[16]; p.pu = (const float*)d_in[17]; p.pv = (const float*)d_in[18]; p.ln2_g = (const float*)d_in[19]; p.ln2_b = (const float*)d_in[20];
    p.out = (float*)d_out; p.ws = (unsigned char*)d_ws;
    (void)hipMemsetAsync((char*)d_ws + WS_CTL, 0, CTL_BYTES, stream);
    const dim3 blk(NTHR);
    hipLaunchKernelGGL(k_prep, dim3(256), blk, LDS_BYTES, stream, p);
    hipLaunchKernelGGL(k_mod, dim3(256), blk, LDS_BYTES, stream, p);
    for (int l = 0; l < NL; ++l) {
        hipLaunchKernelGGL(k_tables, dim3(1024), blk, 0, stream, p, l);
        if (l == 0) hipLaunchKernelGGL(k_rowA, dim3(1024), blk, 0, stream, p, l);
        hipLaunchKernelGGL(k_gemmB, dim3(1024), blk, 0, stream, p, l);
        hipLaunchKernelGGL(k_gemmC1, dim3(1024), blk, 0, stream, p, l);
        hipLaunchKernelGGL(k_gemmC2, dim3(1024), blk, 0, stream, p, l);
        hipLaunchKernelGGL(k_convk, dim3(1024), blk, 0, stream, p, l);
        hipLaunchKernelGGL(k_mla_naive, dim3(2048), dim3(256), 0, stream, p);
        hipLaunchKernelGGL(k_sb_naive, dim3(4096), dim3(128), 0, stream, p);
        hipLaunchKernelGGL(k_gemmE, dim3(1024), blk, 0, stream, p, l);
        hipLaunchKernelGGL(k_rowF, dim3(1024), blk, 0, stream, p, l);
        hipLaunchKernelGGL(k_gemmG, dim3(1024), blk, 0, stream, p, l);
        hipLaunchKernelGGL(k_topk, dim3(512), blk, LDS_BYTES, stream, p, l);
        hipLaunchKernelGGL(k_experts, dim3(1024), blk, 0, stream, p, l);
    }
}
```

```cpp
#include <hip/hip_runtime.h>
#include <hip/hip_cooperative_groups.h>
#include <cstdio>
#include <cstdint>

#define LAS __attribute__((address_space(3)))
typedef unsigned short bf16_t;
typedef short bf16x8 __attribute__((ext_vector_type(8)));
typedef float f32x4 __attribute__((ext_vector_type(4)));
typedef float f32x16 __attribute__((ext_vector_type(16)));
typedef unsigned u32x4 __attribute__((ext_vector_type(4)));
typedef unsigned u32x2 __attribute__((ext_vector_type(2)));

constexpr int D = 1024, NB = 16, SEQ = 2048, T = NB * SEQ, NL = 2;
constexpr int NPROJ = 2048;
constexpr int NEXP = 16384;
constexpr float LN_EPS = 1e-5f, RMS_EPS = 1e-6f;
constexpr float ALPHA = 1.4142135623730951f;
constexpr float LOG2E = 1.4426950408889634f;
constexpr float CQ = 0.10206207261596577f * LOG2E;
constexpr float SBQ_SCALE = 0.125f * LOG2E;
constexpr int PC_QLAT = 0, PC_KVLAT = 256, PC_CB = 384, PC_CC = 640, PC_CH = 896, PC_SBQ = 1152, PC_SBK = 1408, PC_SBV = 1664, PC_KROPE = 1920, PC_END = 1952;

constexpr size_t MiB = 1u << 20;
constexpr size_t WS_CTL = 0, CTL_BYTES = 1 * MiB;
constexpr size_t WS_SSQQ = 6 * MiB, WS_SSQKV = 7 * MiB;
constexpr size_t WS_MOD = 1 * MiB;
constexpr size_t WS_COS = 2 * MiB, WS_SIN = 4 * MiB;
constexpr size_t WS_WIN = 8 * MiB;
constexpr size_t WS_WO = 16 * MiB;
constexpr size_t WS_WQ = 20 * MiB;
constexpr size_t WS_WUQ = 28 * MiB;
constexpr size_t WS_WUKV = 29 * MiB;
constexpr size_t WS_K1 = 30 * MiB, WS_K2 = 30 * MiB + 512 * 1024;
constexpr size_t WS_IDX = 32 * MiB, WS_QLAT = 32 * MiB;
constexpr size_t WS_GATE = 48 * MiB, WS_KVLAT = 48 * MiB;
constexpr size_t WS_H1 = 64 * MiB, WS_CONCAT = 64 * MiB;
constexpr size_t WS_H2 = 128 * MiB;
constexpr size_t WS_SBX = 128 * MiB;
constexpr int SBX_PITCH = 832;
constexpr size_t WS_PROJ = 192 * MiB, WS_PQ = 192 * MiB;
constexpr size_t WS_X2 = 320 * MiB;
constexpr size_t WS_H2Q = 384 * MiB;
constexpr size_t WS_HQS = 7 * MiB + 512 * 1024;
constexpr size_t WS_UB = 448 * MiB, WS_VB = 480 * MiB;
constexpr size_t WS_END = 512 * MiB;
constexpr size_t OUT_Q = 0, OUT_K = 48 * MiB, OUT_V = 96 * MiB;

constexpr int LDS_BYTES = 147456;
constexpr int NTHR = 512;

struct Params {
    const float *x, *c; const int* pos;
    const float *ada_w, *ada_b, *w_in, *qg, *kvg, *w_uq, *w_ukv, *conv_w, *w_o, *ln1_g, *ln1_b, *wq, *k1, *k2, *pu, *pv, *ln2_g, *ln2_b;
    float* out; unsigned char* ws;
};

typedef const __attribute__((address_space(4))) Params* KParams;
__device__ __forceinline__ unsigned pk2(float lo, float hi) { unsigned r; asm("v_cvt_pk_bf16_f32 %0, %1, %2" : "=v"(r) : "v"(lo), "v"(hi)); return r; }
__device__ __forceinline__ unsigned f2bf(float f) { return pk2(f, f) & 0xffffu; }
__device__ __forceinline__ float bf_lo(unsigned u) { return __builtin_bit_cast(float, u << 16); }
__device__ __forceinline__ float bf_hi(unsigned u) { return __builtin_bit_cast(float, u & 0xffff0000u); }
__device__ __forceinline__ float bf2f(bf16_t h) { return __builtin_bit_cast(float, (unsigned)h << 16); }
template <int M> __device__ __forceinline__ float sxor(float v) {
    static_assert(M == 1 || M == 2 || M == 4 || M == 8 || M == 16, "sxor mask");
    return __builtin_bit_cast(float, __builtin_amdgcn_ds_swizzle(__builtin_bit_cast(int, v), 0x1F | (M << 10)));
}
__device__ __forceinline__ void swap32(float& a, float& b) {
    const auto r = __builtin_amdgcn_permlane32_swap(__builtin_bit_cast(unsigned, a), __builtin_bit_cast(unsigned, b), false, false);
    a = __builtin_bit_cast(float, (unsigned)r[0]); b = __builtin_bit_cast(float, (unsigned)r[1]);
}
__device__ __forceinline__ void swap16(float& a, float& b) {
    const auto r = __builtin_amdgcn_permlane16_swap(__builtin_bit_cast(unsigned, a), __builtin_bit_cast(unsigned, b), false, false);
    a = __builtin_bit_cast(float, (unsigned)r[0]); b = __builtin_bit_cast(float, (unsigned)r[1]);
}
__device__ __forceinline__ float sum_x32(float v) { float a = v, b = v; swap32(a, b); return a + b; }
__device__ __forceinline__ float max_x32(float v) { float a = v, b = v; swap32(a, b); return fmaxf(a, b); }
__device__ __forceinline__ float wave_sum(float v) {
    v += sxor<1>(v); v += sxor<2>(v); v += sxor<4>(v); v += sxor<8>(v); v += sxor<16>(v);
    return sum_x32(v);
}
__device__ __forceinline__ float wave_max(float v) {
    v = fmaxf(v, sxor<1>(v)); v = fmaxf(v, sxor<2>(v)); v = fmaxf(v, sxor<4>(v)); v = fmaxf(v, sxor<8>(v)); v = fmaxf(v, sxor<16>(v));
    return max_x32(v);
}
template <int M> __device__ __forceinline__ int sxori(int v) { return __builtin_amdgcn_ds_swizzle(v, 0x1F | (M << 10)); }
typedef float f32x2_t __attribute__((ext_vector_type(2)));
typedef int i32x2_t __attribute__((ext_vector_type(2)));
__device__ __forceinline__ float vmaxf(float a, float b) { float r; asm("v_max_f32 %0, %1, %2" : "=v"(r) : "v"(a), "v"(b)); return r; }
__device__ __forceinline__ float vminf(float a, float b) { float r; asm("v_min_f32 %0, %1, %2" : "=v"(r) : "v"(a), "v"(b)); return r; }

__device__ __forceinline__ int opaque_tid(int wid_s) { int lane; asm volatile("v_mbcnt_lo_u32_b32 %0, -1, 0\n\tv_mbcnt_hi_u32_b32 %0, -1, %0" : "=v"(lane)); return (wid_s << 6) | lane; }

#define OPQF(name, val) float name = (val); asm volatile("" : "+v"(name))
__device__ __forceinline__ float gelu_exact(float x) {
    OPQF(P, 0.3275911f); OPQF(A1, 0.254829592f); OPQF(A2, -0.284496736f); OPQF(A3, 1.421413741f); OPQF(A4, -1.453152027f); OPQF(A5, 1.061405429f); OPQF(RS2, 0.70710678118654752f);
    const float z = fabsf(x) * RS2, t = __builtin_amdgcn_rcpf(1.0f + P * z);
    const float poly = ((((A5 * t + A4) * t + A3) * t + A2) * t + A1) * t;
    const float erfa = 1.0f - poly * __expf(-z * z);
    const float erfx = x < 0.f ? -erfa : erfa;
    return 0.5f * x * (1.0f + erfx);
}
__device__ __forceinline__ void sincos_f32(float ang, float& sn, float& cs) {
    double TWO_OVER_PI = 0.63661977236758134; asm volatile("" : "+v"(TWO_OVER_PI));
    double PI_OVER_2 = 1.5707963267948966; asm volatile("" : "+v"(PI_OVER_2));
    const double a = (double)ang, nq = __builtin_rint(a * TWO_OVER_PI);
    const float r = (float)__builtin_fma(-nq, PI_OVER_2, a), r2 = r * r;
    const int q = (int)nq & 3;
    OPQF(S3, -1.6666667e-1f); OPQF(S5, 8.3333333e-3f); OPQF(S7, -1.9841270e-4f); OPQF(S9, 2.7557319e-6f);
    OPQF(C2, -0.5f); OPQF(C4, 4.1666667e-2f); OPQF(C6, -1.3888889e-3f); OPQF(C8, 2.4801587e-5f); OPQF(C10, -2.7557319e-7f);
    const float s = r + r * r2 * (S3 + r2 * (S5 + r2 * (S7 + r2 * S9)));
    const float c = 1.0f + r2 * (C2 + r2 * (C4 + r2 * (C6 + r2 * (C8 + r2 * C10))));
    sn = (q == 0) ? s : (q == 1) ? c : (q == 2) ? -s : -c;
    cs = (q == 0) ? c : (q == 1) ? -s : (q == 2) ? -c : s;
}
__device__ const float ROPE_INV_FREQ[16] = {1.0f, 0.5623413251903491f, 0.31622776601683794f, 0.1778279410038923f, 0.1f, 0.05623413251903491f, 0.03162277660168379f, 0.01778279410038923f,
                                            0.01f, 0.005623413251903491f, 0.0031622776601683794f, 0.0017782794100389228f, 0.001f, 0.0005623413251903491f, 0.00031622776601683794f, 0.00017782794100389227f};
__device__ __forceinline__ void transpose_item(const float* W, int ldw, int K, bf16_t* WT, int n_src0, int n_dst0, int k0, const float* kscale, bool zero, LAS float* scr, int lane) {
    if (!zero) {
        f32x4 w[8];
        const float* src = W + (size_t)(k0 + (lane >> 3)) * ldw + n_src0 + 4 * (lane & 7);
#pragma unroll
        for (int u = 0; u < 8; ++u) w[u] = *(const f32x4*)(src + (size_t)(8 * u) * ldw);
#pragma unroll
        for (int u = 0; u < 8; ++u) { const int kk = 8 * u + (lane >> 3); f32x4 v = w[u]; if (kscale) { const float sc = kscale[k0 + kk]; v.x *= sc; v.y *= sc; v.z *= sc; v.w *= sc; }
            LAS float* d = scr + kk * 33 + 4 * (lane & 7); d[0] = v.x; d[1] = v.y; d[2] = v.z; d[3] = v.w; }
    }
    asm volatile("s_waitcnt lgkmcnt(0)" ::: "memory");
    const int c = lane & 7;
#pragma unroll
    for (int j = 0; j < 4; ++j) {
        const int n = (lane >> 3) + 8 * j; const LAS float* s = scr + (8 * c) * 33 + n;
        u32x4 o;
        if (zero) { unsigned z = 0u; asm volatile("" : "+v"(z)); o = (u32x4){z, z, z, z}; }
        else { o.x = pk2(s[0 * 33], s[1 * 33]); o.y = pk2(s[2 * 33], s[3 * 33]); o.z = pk2(s[4 * 33], s[5 * 33]); o.w = pk2(s[6 * 33], s[7 * 33]); }
        *(u32x4*)(WT + (size_t)(n_dst0 + n) * K + k0 + 8 * c) = o;
    }
    asm volatile("s_waitcnt lgkmcnt(0)" ::: "memory");
}

__device__ __forceinline__ int proj_src_col(int n) {
    if (n < 384) return n;
    if (n < 1920) return n + 32;
    if (n < 1952) return n - 1920 + 384;
    return -1;
}

__device__ __forceinline__ void phase_prep_weights(KParams p, LAS unsigned char* lds, int bid, int nb, int wid_s) {
    const int tidx = opaque_tid(wid_s);
    const int tid = tidx, lane = tid & 63, wave = tid >> 6;
    LAS float* scr = (LAS float*)(lds + wave * 16384);
    const int gw = bid * 8 + wave, ngw = nb * 8;
    constexpr int I_WIN = 16 * 64, I_WO = 16 * 32, I_WQ = 16 * 64, I_UQ = 4 * 24, I_UKV = 2 * 32;
    constexpr int I_L = I_WIN + I_WO + I_WQ + I_UQ + I_UKV;
    for (int it = gw; it < NL * I_L; it += ngw) {
        const int l = it / I_L; int r = it % I_L;
        if (r < I_WIN) { const int kb = r / 64, nbk = r % 64, n0 = nbk * 32, src = proj_src_col(n0);
            transpose_item(p->w_in + (size_t)l * D * PC_END, PC_END, D, (bf16_t*)(p->ws + WS_WIN) + (size_t)l * NPROJ * D, src < 0 ? 0 : src, n0, kb * 64, nullptr, src < 0, scr, lane); continue; }
        r -= I_WIN;
        if (r < I_WO) { const int kb = r / 32, nbk = r % 32;
            transpose_item(p->w_o + (size_t)l * D * D, D, D, (bf16_t*)(p->ws + WS_WO) + (size_t)l * D * D, nbk * 32, nbk * 32, kb * 64, nullptr, false, scr, lane); continue; }
        r -= I_WO;
        if (r < I_WQ) { const int kb = r / 64, nbk = r % 64;
            transpose_item(p->wq + (size_t)l * D * 2048, 2048, D, (bf16_t*)(p->ws + WS_WQ) + (size_t)l * 2048 * D, nbk * 32, nbk * 32, kb * 64, nullptr, false, scr, lane); continue; }
        r -= I_WQ;
        if (r < I_UQ) { const int kb = r / 24, nbk = r % 24;
            transpose_item(p->w_uq + (size_t)l * 256 * 768, 768, 256, (bf16_t*)(p->ws + WS_WUQ) + (size_t)l * 768 * 256, nbk * 32, nbk * 32, kb * 64, p->qg + l * 256, false, scr, lane); continue; }
        r -= I_UQ;
        { const int kb = r / 32, nbk = r % 32;
            transpose_item(p->w_ukv + (size_t)l * 128 * 1024, 1024, 128, (bf16_t*)(p->ws + WS_WUKV) + (size_t)l * 1024 * 128, nbk * 32, nbk * 32, kb * 64, p->kvg + l * 128, false, scr, lane); }
    }
    const int gt = bid * NTHR + tid, ngt = nb * NTHR;
    bf16_t* k1b = (bf16_t*)(p->ws + WS_K1); bf16_t* k2b = (bf16_t*)(p->ws + WS_K2);
    for (int i = gt; i < NL * 8 * 128 * 128; i += ngt) { k1b[i] = (bf16_t)f2bf(p->k1[i]); k2b[i] = (bf16_t)f2bf(p->k2[i]); }
    float* cosT = (float*)(p->ws + WS_COS); float* sinT = (float*)(p->ws + WS_SIN);
    for (int i = gt; i < T * 16; i += ngt) {
        const int t = i >> 4, j = i & 15;
        const float ang = (float)p->pos[t] * ROPE_INV_FREQ[j];
        float sn, cs; sincos_f32(ang, sn, cs);
        cosT[i] = cs; sinT[i] = sn;
    }
}

constexpr size_t TAB4_LAYER = (size_t)NEXP * 512;
constexpr float U_STEP = 0.3352f / 32.0f, V_STEP = 0.3352f * 0.17677669529663687f;
__device__ __forceinline__ unsigned enc_i4b(float x, float sc) { return (unsigned)__builtin_amdgcn_fmed3f(__builtin_fmaf(x, sc, 8.0f), 0.0f, 15.5f); }
__device__ __forceinline__ u32x4 pack32_i4(const f32x4* src, float sc, unsigned flip) {
    unsigned w[4];
#pragma unroll
    for (int d = 0; d < 4; ++d) {
        const f32x4 a = src[2 * d], b = src[2 * d + 1];
        w[d] = (enc_i4b(a.x, sc) | (enc_i4b(a.y, sc) << 4) | (enc_i4b(a.z, sc) << 8) | (enc_i4b(a.w, sc) << 12) | (enc_i4b(b.x, sc) << 16) | (enc_i4b(b.y, sc) << 20) | (enc_i4b(b.z, sc) << 24) | (enc_i4b(b.w, sc) << 28)) ^ flip;
    }
    return (u32x4){w[0], w[1], w[2], w[3]};
}
__device__ __forceinline__ void phase_prep_tables(KParams p, int bid, int nb, int wid_s) {
    const int tidx = opaque_tid(wid_s);
    const int gt = bid * NTHR + tidx, ngt = nb * NTHR;
    const f32x4* su = (const f32x4*)p->pu; const f32x4* sv = (const f32x4*)p->pv;
    unsigned char* du = p->ws + WS_UB; unsigned char* dv = p->ws + WS_VB;
    for (int i = gt; i < NL * NEXP * D / 32; i += ngt) {
        const int c32 = i & 31, le = i >> 5, e = le & (NEXP - 1), l = le >> 14;
        const size_t dst = ((((size_t)l * 4 + (c32 >> 3)) * NEXP + e) * 128) + (c32 & 7) * 16;
        *(u32x4*)(du + dst) = pack32_i4(su + 8 * (size_t)i, 1.0f / U_STEP, 0x88888888u);
        *(u32x4*)(dv + dst) = pack32_i4(sv + 8 * (size_t)i, 1.0f / V_STEP, 0x80808080u);
    }
}

__device__ __forceinline__ void phase_mod(KParams p, LAS unsigned char* lds, int bid, int nb, int wid_s) {
    const int tidx = opaque_tid(wid_s);
    const int tid = tidx, lane = tid & 63, wave = tid >> 6;
    LAS float* cact = (LAS float*)lds;
    LAS float* part = (LAS float*)(lds + 65536);
    if (bid >= NL * 96) return;
    for (int i = tid; i < NB * D; i += NTHR) { const float v = p->c[i]; cact[(i & 1023) * 16 + (i >> 10)] = v / (1.0f + expf(-v)); }
    __syncthreads();
    float* mod = (float*)(p->ws + WS_MOD);
    for (int item = bid; item < NL * 96; item += nb) {
        const int l = item / 96, col0 = (item % 96) * 64;
        const int kq = lane >> 4, c4 = 4 * (lane & 15);
        const float* W = p->ada_w + (size_t)l * D * 6144 + (size_t)(wave * 128 + kq) * 6144 + col0 + c4;
        f32x4 acc[16];
#pragma unroll
        for (int b = 0; b < 16; ++b) acc[b] = (f32x4){0.f, 0.f, 0.f, 0.f};
#pragma unroll 1
        for (int kb = 0; kb < 128; kb += 32) {
            f32x4 w[8];
#pragma unroll
            for (int u = 0; u < 8; ++u) w[u] = *(const f32x4*)(W + (size_t)(kb + 4 * u) * 6144);
#pragma unroll
            for (int u = 0; u < 8; ++u) {
                const LAS f32x4* cp = (const LAS f32x4*)(cact + (wave * 128 + kb + 4 * u + kq) * 16);
#pragma unroll
                for (int q = 0; q < 4; ++q) { const f32x4 cq = cp[q]; acc[4 * q] += cq.x * w[u]; acc[4 * q + 1] += cq.y * w[u]; acc[4 * q + 2] += cq.z * w[u]; acc[4 * q + 3] += cq.w * w[u]; }
                __builtin_amdgcn_sched_barrier(0);
            }
        }
#pragma unroll
        for (int b = 0; b < 16; ++b) {
            f32x4 a = acc[b];
            a.x += sxor<16>(a.x); a.y += sxor<16>(a.y); a.z += sxor<16>(a.z); a.w += sxor<16>(a.w);
            a.x = sum_x32(a.x); a.y = sum_x32(a.y); a.z = sum_x32(a.z); a.w = sum_x32(a.w);
            if (lane < 16) *(LAS f32x4*)(part + (wave * 16 + b) * 64 + c4) = a;
        }
        __syncthreads();
        for (int o = tid; o < 1024; o += NTHR) {
            const int b = o >> 6, cl = o & 63; float s = p->ada_b[l * 6144 + col0 + cl];
#pragma unroll
            for (int w = 0; w < 8; ++w) s += part[(w * 16 + b) * 64 + cl];
            mod[((size_t)l * 16 + b) * 6144 + col0 + cl] = s;
        }
        __syncthreads();
    }
}

__device__ __forceinline__ void row_load_f32(const float* row, int lane, float (&v)[16]) {
    const f32x4 a = *(const f32x4*)(row + 8 * lane), b = *(const f32x4*)(row + 8 * lane + 4), c = *(const f32x4*)(row + 512 + 8 * lane), d = *(const f32x4*)(row + 512 + 8 * lane + 4);
    v[0] = a.x; v[1] = a.y; v[2] = a.z; v[3] = a.w; v[4] = b.x; v[5] = b.y; v[6] = b.z; v[7] = b.w;
    v[8] = c.x; v[9] = c.y; v[10] = c.z; v[11] = c.w; v[12] = d.x; v[13] = d.y; v[14] = d.z; v[15] = d.w;
}
__device__ __forceinline__ void row_store_f32(float* row, int lane, const float (&v)[16]) {
    *(f32x4*)(row + 8 * lane) = (f32x4){v[0], v[1], v[2], v[3]}; *(f32x4*)(row + 8 * lane + 4) = (f32x4){v[4], v[5], v[6], v[7]};
    *(f32x4*)(row + 512 + 8 * lane) = (f32x4){v[8], v[9], v[10], v[11]}; *(f32x4*)(row + 512 + 8 * lane + 4) = (f32x4){v[12], v[13], v[14], v[15]};
}
__device__ __forceinline__ void row_load_bf16(const bf16_t* row, int lane, float (&v)[16]) {
    const u32x4 a = *(const u32x4*)(row + 8 * lane), b = *(const u32x4*)(row + 512 + 8 * lane);
    v[0] = bf_lo(a.x); v[1] = bf_hi(a.x); v[2] = bf_lo(a.y); v[3] = bf_hi(a.y); v[4] = bf_lo(a.z); v[5] = bf_hi(a.z); v[6] = bf_lo(a.w); v[7] = bf_hi(a.w);
    v[8] = bf_lo(b.x); v[9] = bf_hi(b.x); v[10] = bf_lo(b.y); v[11] = bf_hi(b.y); v[12] = bf_lo(b.z); v[13] = bf_hi(b.z); v[14] = bf_lo(b.w); v[15] = bf_hi(b.w);
}
__device__ __forceinline__ void row_store_bf16(bf16_t* row, int lane, const float (&v)[16]) {
    *(u32x4*)(row + 8 * lane) = (u32x4){pk2(v[0], v[1]), pk2(v[2], v[3]), pk2(v[4], v[5]), pk2(v[6], v[7])};
    *(u32x4*)(row + 512 + 8 * lane) = (u32x4){pk2(v[8], v[9]), pk2(v[10], v[11]), pk2(v[12], v[13]), pk2(v[14], v[15])};
}
__device__ __forceinline__ void row_normalize(float (&v)[16]) {
    float s = 0.f;
#pragma unroll
    for (int i = 0; i < 16; ++i) s += v[i];
    const float mean = wave_sum(s) * (1.0f / D);
    float q = 0.f;
#pragma unroll
    for (int i = 0; i < 16; ++i) { v[i] -= mean; q += v[i] * v[i]; }
    const float rstd = 1.0f / sqrtf(wave_sum(q) * (1.0f / D) + LN_EPS);
#pragma unroll
    for (int i = 0; i < 16; ++i) v[i] *= rstd;
}
__device__ __forceinline__ void row_modulate(float (&v)[16], const float* shift, const float* scale, int lane) {
    float sh[16], sc[16]; row_load_f32(shift, lane, sh); row_load_f32(scale, lane, sc);
#pragma unroll
    for (int i = 0; i < 16; ++i) v[i] = v[i] * (1.0f + sc[i]) + sh[i];
}
__device__ __forceinline__ void row_affine(float (&v)[16], const float* g, const float* b, int lane) {
    float gg[16], bb[16]; row_load_f32(g, lane, gg); row_load_f32(b, lane, bb);
#pragma unroll
    for (int i = 0; i < 16; ++i) v[i] = v[i] * gg[i] + bb[i];
}

__device__ __forceinline__ void phase_rowA(KParams p, int l, const float* xin, int bid, int nb, int wid_s) {
    const int tidx = opaque_tid(wid_s);
    const int lane = tidx & 63, gw = bid * 8 + (tidx >> 6), ngw = nb * 8;
    const float* mod = (const float*)(p->ws + WS_MOD) + (size_t)l * 16 * 6144;
    bf16_t* H1 = (bf16_t*)(p->ws + WS_H1);
    for (int tb = 16 * gw; tb < T; tb += 16 * ngw) {
        const float* m = mod + (size_t)(tb / SEQ) * 6144;
        float sh[16], sc[16]; row_load_f32(m, lane, sh); row_load_f32(m + 1024, lane, sc);
        float nx[16]; row_load_f32(xin + (size_t)tb * D, lane, nx);
#pragma unroll 1
        for (int i = 0; i < 16; ++i) { const int t = tb + i;
            float v[16];
#pragma unroll
            for (int q = 0; q < 16; ++q) v[q] = nx[q];
            if (i + 1 < 16) row_load_f32(xin + (size_t)(t + 1) * D, lane, nx);
            row_normalize(v);
#pragma unroll
            for (int q = 0; q < 16; ++q) v[q] = v[q] * (1.0f + sc[q]) + sh[q];
            row_store_bf16(H1 + (size_t)t * D, lane, v);
        }
    }
}
__device__ __forceinline__ bf16_t* x1_buffer(KParams p, int l) { return (l == NL - 1) ? (bf16_t*)(p->ws + WS_H1) : (bf16_t*)p->out; }
__device__ __forceinline__ void phase_rowF(KParams p, int l, int bid, int nb, int wid_s) {
    const int tidx = opaque_tid(wid_s);
    const int lane = tidx & 63, gw = bid * 8 + (tidx >> 6), ngw = nb * 8;
    const float* mod = (const float*)(p->ws + WS_MOD) + (size_t)l * 16 * 6144;
    bf16_t* H2 = (bf16_t*)(p->ws + WS_H2); unsigned char* H2Q = p->ws + WS_H2Q; float* HQS = (float*)(p->ws + WS_HQS);
    const bf16_t* Y = (const bf16_t*)p->out; bf16_t* X1 = x1_buffer(p, l);
    for (int tb = 16 * gw; tb < T; tb += 16 * ngw) {
        const float* m = mod + (size_t)(tb / SEQ) * 6144;
        float gg[16], bb[16], sh[16], sc[16];
        row_load_f32(p->ln1_g + l * D, lane, gg); row_load_f32(p->ln1_b + l * D, lane, bb); row_load_f32(m + 3072, lane, sh); row_load_f32(m + 4096, lane, sc);
        u32x4 na = *(const u32x4*)(Y + (size_t)tb * D + 8 * lane), nb2 = *(const u32x4*)(Y + (size_t)tb * D + 512 + 8 * lane);
#pragma unroll 1
        for (int i = 0; i < 16; ++i) { const int t = tb + i;
            const u32x4 a = na, b = nb2;
            if (i + 1 < 16) { na = *(const u32x4*)(Y + (size_t)(t + 1) * D + 8 * lane); nb2 = *(const u32x4*)(Y + (size_t)(t + 1) * D + 512 + 8 * lane); }
            float v[16];
            v[0] = bf_lo(a.x); v[1] = bf_hi(a.x); v[2] = bf_lo(a.y); v[3] = bf_hi(a.y); v[4] = bf_lo(a.z); v[5] = bf_hi(a.z); v[6] = bf_lo(a.w); v[7] = bf_hi(a.w);
            v[8] = bf_lo(b.x); v[9] = bf_hi(b.x); v[10] = bf_lo(b.y); v[11] = bf_hi(b.y); v[12] = bf_lo(b.z); v[13] = bf_hi(b.z); v[14] = bf_lo(b.w); v[15] = bf_hi(b.w);
            row_normalize(v);
#pragma unroll
            for (int q = 0; q < 16; ++q) v[q] = v[q] * gg[q] + bb[q];
            row_store_bf16(X1 + (size_t)t * D, lane, v);
            row_normalize(v);
#pragma unroll
            for (int q = 0; q < 16; ++q) v[q] = v[q] * (1.0f + sc[q]) + sh[q];
            row_store_bf16(H2 + (size_t)t * D, lane, v);
            float am = 0.f;
#pragma unroll
            for (int q = 0; q < 16; ++q) am = fmaxf(am, fabsf(v[q]));
            am = fmaxf(wave_max(am), 1.0e-20f);
            const float qs = 119.0f / am;
            unsigned dg[4] = {0u, 0u, 0u, 0u}; int hsum = 0;
#pragma unroll
            for (int q = 0; q < 16; ++q) {
                const int h8 = (int)__builtin_rintf(v[q] * qs); hsum += h8;
                dg[2 * (q >> 3)] |= (unsigned)(((h8 + 8) >> 4) & 15) << (4 * (q & 7));
                dg[2 * (q >> 3) + 1] |= (unsigned)(h8 & 15) << (4 * (q & 7));
            }
            const float hs = wave_sum((float)hsum);
            unsigned char* hq = H2Q + (size_t)t * 1024 + (lane >> 2) * 32 + (lane & 3) * 4;
            *(unsigned*)(hq) = dg[0]; *(unsigned*)(hq + 16) = dg[1]; *(unsigned*)(hq + 512) = dg[2]; *(unsigned*)(hq + 528) = dg[3];
            if (lane == 0) *(f32x2_t*)(HQS + 2 * (size_t)t) = (f32x2_t){am * (U_STEP / 119.0f), 0.5f * hs};
        }
    }
}

__device__ __forceinline__ void store_bf16x4(bf16_t* p, f32x4 v) { *(u32x2*)p = (u32x2){pk2(v.x, v.y), pk2(v.z, v.w)}; }

#define OPQ_S(x) asm volatile("" : "+s"(x))
struct EpiProj {
    static constexpr bool WIDE = true, ROWVAL = false; KParams p;
    __device__ __forceinline__ void rebase() { OPQ_S(p); }
    __device__ __forceinline__ void operator()(int row, int col, f32x4 v0, f32x4 v1) const {
        unsigned char* ws = p->ws;
        bf16_t* proj = (bf16_t*)(ws + WS_PROJ); bf16_t* qlat = (bf16_t*)(ws + WS_QLAT); bf16_t* kvlat = (bf16_t*)(ws + WS_KVLAT);
        float* ssq_q = (float*)(ws + WS_SSQQ); float* ssq_kv = (float*)(ws + WS_SSQKV);
        const int cb = col & ~31;
        const u32x4 w = (u32x4){pk2(v0.x, v0.y), pk2(v0.z, v0.w), pk2(v1.x, v1.y), pk2(v1.z, v1.w)};
        if (cb < 256) *(u32x4*)(qlat + (size_t)row * 256 + col) = w;
        else if (cb < 384) *(u32x4*)(kvlat + (size_t)row * 128 + col - 256) = w;
        else if (cb >= PC_SBQ && cb < PC_KROPE) *(u32x4*)((bf16_t*)(ws + WS_SBX) + (size_t)row * SBX_PITCH + (col - PC_SBQ)) = w;
        else *(u32x4*)(proj + (size_t)row * NPROJ + col) = w;
        if (cb < 384) {
            float s = v0.x * v0.x + v0.y * v0.y + v0.z * v0.z + v0.w * v0.w + v1.x * v1.x + v1.y * v1.y + v1.z * v1.z + v1.w * v1.w;
            s += sxor<16>(s); s = sum_x32(s);
            if ((col & 31) == 0) { if (cb < 256) ssq_q[(size_t)row * 8 + (cb >> 5)] = s; else ssq_kv[(size_t)row * 4 + ((cb - 256) >> 5)] = s; }
        }
    }
};
struct EpiQ {
    static constexpr bool WIDE = false, ROWVAL = true; KParams p;
    __device__ __forceinline__ void rebase() { OPQ_S(p); }
    __device__ __forceinline__ float rowval(int row) const {
        const float* ssq = (const float*)(p->ws + WS_SSQQ);
        const f32x4 sa = *(const f32x4*)(ssq + (size_t)row * 8), sb = *(const f32x4*)(ssq + (size_t)row * 8 + 4);
        return CQ * __builtin_amdgcn_rsqf((((sa.x + sa.y) + (sa.z + sa.w)) + ((sb.x + sb.y) + (sb.z + sb.w))) * (1.0f / 256.0f) + RMS_EPS);
    }
    __device__ __forceinline__ void operator()(int row, int col, f32x4 v0, f32x4 v1, float rs) const {
        unsigned char* ws = p->ws; unsigned char* out = (unsigned char*)p->out;
        bf16_t* q = (bf16_t*)(out + OUT_Q); const float* cosT = (const float*)(ws + WS_COS); const float* sinT = (const float*)(ws + WS_SIN);
        v0 *= rs; v1 *= rs;
        const int cb = col >> 5;
        if (cb % 3 == 2) {
            const int i0 = col & 31;
            const f32x4 cs = *(const f32x4*)(cosT + (size_t)row * 16 + i0), sn = *(const f32x4*)(sinT + (size_t)row * 16 + i0);
            const f32x4 a = v0 * cs - v1 * sn, b = v1 * cs + v0 * sn; v0 = a; v1 = b;
        }
        { const int hq = col / 96, cq = col - 96 * hq; bf16_t* qr = q + ((size_t)hq * T + row) * 96 + cq;
          store_bf16x4(qr, v0); store_bf16x4(qr + 16, v1); }
    }
};
struct EpiKV {
    static constexpr bool WIDE = true, ROWVAL = true, PRE = false; KParams p;
    __device__ __forceinline__ void rebase() { OPQ_S(p); }
    __device__ __forceinline__ float rowval(int row) const {
        const float* ssq = (const float*)(p->ws + WS_SSQKV);
        const f32x4 sa = *(const f32x4*)(ssq + (size_t)row * 4);
        return __builtin_amdgcn_rsqf(((sa.x + sa.y) + (sa.z + sa.w)) * (1.0f / 128.0f) + RMS_EPS);
    }
    __device__ __forceinline__ void operator()(int row, int col, f32x4 v0, f32x4 v1, float rs) const {
        unsigned char* out = (unsigned char*)p->out;
        bf16_t* k = (bf16_t*)(out + OUT_K); bf16_t* v = (bf16_t*)(out + OUT_V);
        v0 *= rs; v1 *= rs;
        const int h = col >> 7, j = col & 127;
        const u32x4 w = (u32x4){pk2(v0.x, v0.y), pk2(v0.z, v0.w), pk2(v1.x, v1.y), pk2(v1.z, v1.w)};
        if (j < 64) *(u32x4*)(k + ((size_t)h * T + row) * 96 + j) = w;
        else *(u32x4*)(v + (((size_t)h * (T / 64) + (row >> 6)) * 8 + ((j - 64) >> 3)) * 512 + (row & 63) * 8) = w;
    }
};
struct EpiY {
    static constexpr bool WIDE = true, ROWVAL = false, PRE = false; KParams p; int l;
    __device__ __forceinline__ void rebase() { OPQ_S(p); OPQ_S(l); }
    __device__ __forceinline__ void operator()(int row, int col, f32x4 v0, f32x4 v1) const {
        bf16_t* y = (bf16_t*)p->out; const float* gate = (const float*)(p->ws + WS_MOD) + (size_t)l * 16 * 6144 + 2048;
        const float* g = gate + (size_t)(row / SEQ) * 6144 + col; bf16_t* yr = y + (size_t)row * D + col;
        const f32x4 g0 = *(const f32x4*)g, g1 = *(const f32x4*)(g + 4);
        f32x4 x0, x1;
        if (l == 0) { const float* xr = p->x + (size_t)row * D + col; x0 = *(const f32x4*)xr; x1 = *(const f32x4*)(xr + 4); }
        else { const bf16_t* xr = (const bf16_t*)(p->ws + WS_X2) + (size_t)row * D + col; const u32x4 a = *(const u32x4*)xr;
               x0 = (f32x4){bf_lo(a.x), bf_hi(a.x), bf_lo(a.y), bf_hi(a.y)}; x1 = (f32x4){bf_lo(a.z), bf_hi(a.z), bf_lo(a.w), bf_hi(a.w)}; }
        const f32x4 o0 = ALPHA * x0 + (1.0f + g0) * v0, o1 = ALPHA * x1 + (1.0f + g1) * v1;
        *(u32x4*)yr = (u32x4){pk2(o0.x, o0.y), pk2(o0.z, o0.w), pk2(o1.x, o1.y), pk2(o1.z, o1.w)};
    }
};
struct EpiBf {
    static constexpr bool WIDE = true, ROWVAL = false; KParams p;
    __device__ __forceinline__ void rebase() { OPQ_S(p); }
    __device__ __forceinline__ void operator()(int row, int col, f32x4 v0, f32x4 v1) const { bf16_t* o = (bf16_t*)(p->ws + WS_PQ);
        const int c = col & 255, d = c & 127;
        const size_t frag = ((((size_t)(col >> 8) * (T / 32) + (row >> 5)) * 2 + (c >> 7)) * 8 + (d >> 4)) * 512 + ((((d >> 3) & 1) * 32 + (row & 31)) * 8);
        *(u32x4*)(o + frag) = (u32x4){pk2(v0.x, v0.y), pk2(v0.z, v0.w), pk2(v1.x, v1.y), pk2(v1.z, v1.w)}; }
};

namespace pg8 {
#define PG8_LAS __attribute__((address_space(3)))
typedef unsigned short bf16_t;
typedef short bf16x8 __attribute__((ext_vector_type(8)));
typedef float f32x4 __attribute__((ext_vector_type(4)));
typedef unsigned u32x4 __attribute__((ext_vector_type(4)));
constexpr int BM = 256, BK = 64, HALF = 128, HTB = HALF * BK * 2  , STAGE_BYTES = 8 * HTB, NXCD = 8, WGM = 8;

__host__ __device__ __forceinline__ int lds_byte(int r, int c) { const int st = (r >> 4) * 2 + (c >> 5), rr = r & 15, cc = c & 31, ob = rr * 64 + cc * 2; return st * 1024 + (ob ^ (((ob >> 9) & 1) << 5)); }
__host__ __device__ __forceinline__ void stage_rc(int b, int& R, int& C) { const int st = b / 1024, sb = b % 1024, swz = sb ^ (((sb >> 9) & 1) << 5); R = (st >> 1) * 16 + swz / 64; C = (st & 1) * 32 + (swz % 64) / 2; }
__host__ __device__ __forceinline__ int perm32(int rho) { const int n = rho >> 4, i = rho & 15; return 8 * (i >> 2) + 4 * n + (i & 3); }

struct Unit { int pm, pn; };
struct Gemm { const bf16_t* A; const bf16_t* Bt; int M, N, K; };

struct StaticOrder {
    int nM, nN, nwg, G, c;
    __host__ __device__ void init(int M, int N, int G_, int c_) { nM = M / BM; nN = N / BM; nwg = nM * nN; G = G_; c = c_; }
    __host__ __device__ bool next(int i, Unit& u) const {
        const long L = (long)i * G + c; if (L >= nwg) return false;
        int wgid = (int)L; { const int q = nwg / NXCD, r = nwg % NXCD, xcd = wgid % NXCD, off = wgid / NXCD; wgid = (xcd < r ? xcd * (q + 1) : r * (q + 1) + (xcd - r) * q) + off; }
        const int nig = WGM * nN, gid = wgid / nig, fm = gid * WGM, gsz = (nM - fm) < WGM ? (nM - fm) : WGM;
        u.pm = fm + ((wgid % nig) % gsz); u.pn = (wgid % nig) / gsz; return true;
    }
    __device__ __forceinline__ void a_ready(const Unit&) const {}
    __device__ __forceinline__ void done(const Unit&) const {}
};
template <class Epi, class Sched, bool ALIGN_EPI = false, bool SP2 = false>
__device__ __forceinline__ void gemm_phase(PG8_LAS unsigned char* lds, const Gemm g, const Sched& S, const Epi& E, int wid_s) {
    const int tid = opaque_tid(wid_s), wid = __builtin_amdgcn_readfirstlane(tid >> 6), lane = tid & 63, wr = wid >> 2, wc = wid & 3, fr = lane & 15, fq = lane >> 4;
    const int K = g.K, nt = K / BK;
    unsigned voffA[2], voffB[2];
#pragma unroll
    for (int i = 0; i < 2; ++i) { int R, C; stage_rc(tid * 16 + i * 8192, R, C); const int Rb = Epi::PERM ? ((R & ~31) + perm32(R & 31)) : R;
        voffA[i] = (unsigned)(R * K + C) * 2u; voffB[i] = (unsigned)(Rb * K + C) * 2u; }
    const size_t kstep = (size_t)(BK * 2);
    const size_t hstep = (size_t)HALF * K * 2;
    const size_t tstep = 2 * hstep;
    const unsigned ldsw = (unsigned)wid * 1024u;
    const unsigned ldsb = (unsigned)__builtin_amdgcn_readfirstlane((int)((unsigned)(__UINTPTR_TYPE__)lds + ldsw));
    int aoff, boff;
#define PG8_SA(b, h) (((b) * 2 + (h)) * HTB)
#define PG8_SB(b, h) ((4 + (b) * 2 + (h)) * HTB)
#define PG8_STAGE(bufoff, gbase, voff) do { _Pragma("unroll") for (int _i = 0; _i < 2; ++_i) { \
        asm volatile("s_mov_b32 m0, %2\n\ts_nop 0\n\tglobal_load_lds_dwordx4 %0, %1" :: "v"((voff)[_i]), "s"((const char*)(gbase)), "s"(ldsb + (unsigned)((bufoff) + _i * 8192)) : "memory", "m0"); } } while (0)
#define PG8_LDA(dst, b, h) do { _Pragma("unroll") for (int m = 0; m < 4; ++m) _Pragma("unroll") for (int k = 0; k < 2; ++k) dst[m][k] = *(const PG8_LAS bf16x8*)(lds + PG8_SA(b, h) + aoff + m * 2048 + k * 1024); } while (0)
#define PG8_LDB(dst, b, h) do { _Pragma("unroll") for (int n = 0; n < 2; ++n) _Pragma("unroll") for (int k = 0; k < 2; ++k) dst[n][k] = *(const PG8_LAS bf16x8*)(lds + PG8_SB(b, h) + boff + n * 2048 + k * 1024); } while (0)
#define PG8_MMA(ai, bj, At, Bt) do { __builtin_amdgcn_s_setprio(1); _Pragma("unroll") for (int m = 0; m < 4; ++m) _Pragma("unroll") for (int n = 0; n < 2; ++n) _Pragma("unroll") for (int k = 0; k < 2; ++k) \
        acc[ai][bj][m][n] = __builtin_amdgcn_mfma_f32_16x16x32_bf16(Bt[n][k], At[m][k], acc[ai][bj][m][n], 0, 0, 0); __builtin_amdgcn_s_setprio(0); } while (0)
#define PG8_WAIT_V(n) asm volatile("s_waitcnt vmcnt(" #n ")" ::: "memory")
#define PG8_WAIT_L(n) asm volatile("s_waitcnt lgkmcnt(" #n ")" ::: "memory")
#define PG8_BAR __builtin_amdgcn_s_barrier()
#define PG8_SCHED __builtin_amdgcn_sched_barrier(0)
    Unit cur, nxt; int ui = 0;
    if (!S.next(0, cur)) return;
    f32x4 acc[2][2][4][2];
#pragma unroll
    for (int a = 0; a < 2; ++a)
#pragma unroll
        for (int b = 0; b < 2; ++b)
#pragma unroll
            for (int m = 0; m < 4; ++m)
#pragma unroll
                for (int n = 0; n < 2; ++n) acc[a][b][m][n] = (f32x4){0.f, 0.f, 0.f, 0.f};
    bf16x8 At[4][2], B0[2][2], B1[2][2];
    const char* cA = (const char*)g.A + (size_t)cur.pm * tstep; const char* cB = (const char*)g.Bt + (size_t)cur.pn * tstep;
    S.a_ready(cur);
    if constexpr (SP2) {
        PG8_STAGE(PG8_SB(0, 0), cB, voffB); PG8_STAGE(PG8_SB(0, 1), cB + hstep, voffB); PG8_STAGE(PG8_SA(0, 0), cA, voffA); PG8_STAGE(PG8_SA(0, 1), cA + hstep, voffA);
        if (wr == 1) PG8_BAR;
        PG8_WAIT_V(2); PG8_BAR;
        PG8_STAGE(PG8_SB(1, 0), cB + kstep, voffB); PG8_STAGE(PG8_SA(1, 0), cA + kstep, voffA); PG8_STAGE(PG8_SB(1, 1), cB + hstep + kstep, voffB);
        PG8_WAIT_V(6); PG8_BAR;
    } else {
        PG8_STAGE(PG8_SB(0, 0), cB, voffB); PG8_STAGE(PG8_SA(0, 0), cA, voffA); PG8_STAGE(PG8_SB(0, 1), cB + hstep, voffB); PG8_STAGE(PG8_SA(0, 1), cA + hstep, voffA);
        if (wr == 1) PG8_BAR;
        PG8_WAIT_V(4); PG8_BAR;
        PG8_STAGE(PG8_SB(1, 0), cB + kstep, voffB); PG8_STAGE(PG8_SA(1, 0), cA + kstep, voffA); PG8_STAGE(PG8_SB(1, 1), cB + hstep + kstep, voffB);
        PG8_WAIT_V(6); PG8_BAR;
    }
    { int fr2 = fr, fq2 = fq; asm volatile("" : "+v"(fr2), "+v"(fq2)); aoff = lds_byte(wr * 64 + fr2, fq2 * 8); boff = lds_byte(wc * 32 + fr2, fq2 * 8); }
    for (;;) {
        const bool has_next = S.next(ui + 1, nxt);
        const char* nA = has_next ? (const char*)g.A + (size_t)nxt.pm * tstep : cA; const char* nB = has_next ? (const char*)g.Bt + (size_t)nxt.pn * tstep : cB;
        for (int t = 0; t < nt; t += 2) {
            const bool last = (t == nt - 2);
            const char* a1 = cA + (size_t)(t + 1) * kstep;
            const char* a2 = last ? nA : cA + (size_t)(t + 2) * kstep; const char* b2 = last ? nB : cB + (size_t)(t + 2) * kstep;
            const char* a3 = a2 + kstep; const char* b3 = b2 + kstep;
            if (last && has_next) S.a_ready(nxt);
            if constexpr (SP2) {
            PG8_LDB(B0, 0, 0); PG8_LDB(B1, 0, 1); PG8_SCHED; PG8_LDA(At, 0, 0); PG8_STAGE(PG8_SA(1, 1), a1 + hstep, voffA);
            PG8_WAIT_V(8); PG8_WAIT_L(0); PG8_BAR; PG8_MMA(0, 0, At, B0); PG8_MMA(0, 1, At, B1); PG8_BAR; PG8_SCHED;
            PG8_LDA(At, 0, 1); PG8_STAGE(PG8_SB(0, 0), b2, voffB); PG8_STAGE(PG8_SB(0, 1), b2 + hstep, voffB); PG8_STAGE(PG8_SA(0, 0), a2, voffA);
            PG8_WAIT_V(8); PG8_WAIT_L(0); PG8_BAR; PG8_MMA(1, 0, At, B0); PG8_MMA(1, 1, At, B1); PG8_BAR; PG8_SCHED;
            PG8_LDB(B0, 1, 0); PG8_LDB(B1, 1, 1); PG8_SCHED; PG8_LDA(At, 1, 0); PG8_STAGE(PG8_SA(0, 1), a2 + hstep, voffA);
            PG8_WAIT_V(8); PG8_WAIT_L(0); PG8_BAR; PG8_MMA(0, 0, At, B0); PG8_MMA(0, 1, At, B1); PG8_BAR; PG8_SCHED;
            PG8_LDA(At, 1, 1); PG8_STAGE(PG8_SB(1, 0), b3, voffB); PG8_STAGE(PG8_SB(1, 1), b3 + hstep, voffB); PG8_STAGE(PG8_SA(1, 0), a3, voffA);
            PG8_WAIT_V(8); PG8_WAIT_L(0); PG8_BAR; PG8_MMA(1, 0, At, B0); PG8_MMA(1, 1, At, B1); PG8_BAR; PG8_SCHED;
            } else {
            PG8_LDB(B0, 0, 0); PG8_SCHED; PG8_LDA(At, 0, 0); PG8_STAGE(PG8_SA(1, 1), a1 + hstep, voffA);
            PG8_WAIT_L(8); PG8_BAR; PG8_WAIT_L(0); PG8_MMA(0, 0, At, B0); PG8_BAR; PG8_SCHED;
            PG8_LDB(B1, 0, 1); PG8_STAGE(PG8_SB(0, 0), b2, voffB);
            PG8_BAR; PG8_WAIT_L(0); PG8_MMA(0, 1, At, B1); PG8_BAR;
            PG8_LDA(At, 0, 1); PG8_STAGE(PG8_SA(0, 0), a2, voffA);
            PG8_BAR; PG8_WAIT_L(0); PG8_MMA(1, 0, At, B0); PG8_BAR; PG8_SCHED;
            PG8_STAGE(PG8_SB(0, 1), b2 + hstep, voffB);
            PG8_WAIT_V(6); PG8_BAR; PG8_MMA(1, 1, At, B1); PG8_BAR;
            PG8_LDB(B0, 1, 0); PG8_SCHED; PG8_LDA(At, 1, 0); PG8_STAGE(PG8_SA(0, 1), a2 + hstep, voffA);
            PG8_WAIT_L(8); PG8_BAR; PG8_WAIT_L(0); PG8_MMA(0, 0, At, B0); PG8_BAR; PG8_SCHED;
            PG8_LDB(B1, 1, 1); PG8_STAGE(PG8_SB(1, 0), b3, voffB);
            PG8_BAR; PG8_WAIT_L(0); PG8_MMA(0, 1, At, B1); PG8_BAR;
            PG8_LDA(At, 1, 1); PG8_STAGE(PG8_SA(1, 0), a3, voffA);
            PG8_BAR; PG8_WAIT_L(0); PG8_MMA(1, 0, At, B0); PG8_BAR; PG8_SCHED;
            PG8_STAGE(PG8_SB(1, 1), b3 + hstep, voffB);
            PG8_WAIT_V(6); PG8_BAR; PG8_MMA(1, 1, At, B1); PG8_BAR;
            }
        }
        if constexpr (ALIGN_EPI) { if (wr == 0) PG8_BAR; }
        if constexpr (!Epi::AFTER_DRAIN) { E(acc, cur, wr, wc, fr, fq); S.done(cur); }
        if (!has_next) break;
#pragma unroll
        for (int a = 0; a < 2; ++a)
#pragma unroll
            for (int b = 0; b < 2; ++b)
#pragma unroll
                for (int m = 0; m < 4; ++m)
#pragma unroll
                    for (int n = 0; n < 2; ++n) acc[a][b][m][n] = (f32x4){0.f, 0.f, 0.f, 0.f};
        cur = nxt; cA = nA; cB = nB; ++ui;
        if constexpr (ALIGN_EPI) { if (wr == 1) PG8_BAR; }
    }
    PG8_WAIT_V(0);
    if constexpr (!ALIGN_EPI) { if (wr == 0) PG8_BAR; }
    PG8_BAR;
    if constexpr (Epi::AFTER_DRAIN) { E.fused(acc, cur, wr, wc, fr, fq, lds, wid, lane); S.done(cur); }
#undef PG8_SA
#undef PG8_SB
#undef PG8_STAGE
#undef PG8_LDA
#undef PG8_LDB
#undef PG8_MMA
#undef PG8_WAIT_V
#undef PG8_WAIT_L
#undef PG8_BAR
#undef PG8_SCHED
}
}

template <class E> struct Pg8Epi {
    static constexpr bool PERM = E::WIDE, AFTER_DRAIN = false; E e;
    __device__ __forceinline__ void operator()(const pg8::f32x4 (&acc)[2][2][4][2], const pg8::Unit& u, int wr, int wc, int fr, int fq) const {
        { int ln; asm volatile("v_mbcnt_lo_u32_b32 %0, -1, 0\n\tv_mbcnt_hi_u32_b32 %0, -1, %0" : "=v"(ln)); fr = ln & 15; fq = ln >> 4; }
        E e = this->e; e.rebase();
        if constexpr (E::ROWVAL) {
            float rv[2][4];
#pragma unroll
            for (int ai = 0; ai < 2; ++ai)
#pragma unroll
                for (int m = 0; m < 4; ++m) rv[ai][m] = e.rowval(u.pm * 256 + ai * 128 + wr * 64 + m * 16 + fr);
#pragma unroll
            for (int ai = 0; ai < 2; ++ai)
#pragma unroll
                for (int m = 0; m < 4; ++m)
#pragma unroll
                    for (int bj = 0; bj < 2; ++bj) { e(u.pm * 256 + ai * 128 + wr * 64 + m * 16 + fr, u.pn * 256 + bj * 128 + wc * 32 + (E::WIDE ? 8 : 4) * fq, acc[ai][bj][m][0], acc[ai][bj][m][1], rv[ai][m]); asm volatile("" ::: "memory"); }
        } else {
#pragma unroll
            for (int ai = 0; ai < 2; ++ai)
#pragma unroll
                for (int m = 0; m < 4; ++m)
#pragma unroll
                    for (int bj = 0; bj < 2; ++bj) { e(u.pm * 256 + ai * 128 + wr * 64 + m * 16 + fr, u.pn * 256 + bj * 128 + wc * 32 + (E::WIDE ? 8 : 4) * fq, acc[ai][bj][m][0], acc[ai][bj][m][1]); asm volatile("" ::: "memory"); }
        }
    }
};
template <class E> __device__ __forceinline__ void gemm_fast(LAS unsigned char* lds, const bf16_t* A, const bf16_t* Bt, int M, int N, int K, const E& e, int bid, int nb, int wid_s) {
    asm volatile("" : "+s"(nb), "+s"(bid));
    pg8::Gemm g{A, Bt, M, N, K}; pg8::StaticOrder S; S.init(M, N, nb, bid);
    Pg8Epi<E> pe{e};
    pg8::gemm_phase<Pg8Epi<E>, pg8::StaticOrder, true, true>(lds, g, S, pe, wid_s);
}

__device__ __forceinline__ void phase_conv_krope(KParams p, int l, int bid, int nb, int wid_s) {
    const int tidx = opaque_tid(wid_s);
    const int lane = tidx & 63, gw = bid * 8 + (tidx >> 6), ngw = nb * 8;
    const bf16_t* proj = (const bf16_t*)(p->ws + WS_PROJ); bf16_t* cc = (bf16_t*)(p->ws + WS_CONCAT); bf16_t* K = (bf16_t*)((unsigned char*)p->out + OUT_K);
    const float* cosT = (const float*)(p->ws + WS_COS); const float* sinT = (const float*)(p->ws + WS_SIN);
    const int c0 = 4 * lane;
    const float* cw = p->conv_w + (size_t)l * 3 * 256 + c0;
    const f32x4 w0 = *(const f32x4*)(cw), w1 = *(const f32x4*)(cw + 256), w2 = *(const f32x4*)(cw + 512);
    const int head = lane >> 3, part = lane & 7, half = part >> 2, i0 = 4 * (part & 3);
    for (int ch = gw; ch < T / 16; ch += ngw) {
        const int t0 = ch * 16;
        f32x4 um1 = {0.f, 0.f, 0.f, 0.f}, um2 = {0.f, 0.f, 0.f, 0.f};
        if ((t0 % SEQ) != 0) {
            const u32x2 a1 = *(const u32x2*)(proj + (size_t)(t0 - 1) * NPROJ + PC_CC + c0), b1 = *(const u32x2*)(proj + (size_t)(t0 - 1) * NPROJ + PC_CH + c0);
            const u32x2 a2 = *(const u32x2*)(proj + (size_t)(t0 - 2) * NPROJ + PC_CC + c0), b2 = *(const u32x2*)(proj + (size_t)(t0 - 2) * NPROJ + PC_CH + c0);
            um1 = (f32x4){bf_lo(a1.x) * bf_lo(b1.x), bf_hi(a1.x) * bf_hi(b1.x), bf_lo(a1.y) * bf_lo(b1.y), bf_hi(a1.y) * bf_hi(b1.y)};
            um2 = (f32x4){bf_lo(a2.x) * bf_lo(b2.x), bf_hi(a2.x) * bf_hi(b2.x), bf_lo(a2.y) * bf_lo(b2.y), bf_hi(a2.y) * bf_hi(b2.y)};
        }
#pragma unroll 1
        for (int tb4 = 0; tb4 < 16; tb4 += 4) {
            u32x2 a[4], b[4], g[4], x1[4], x2[4]; f32x4 cs[4], sn[4];
#pragma unroll
            for (int q = 0; q < 4; ++q) { const size_t t = (size_t)(t0 + tb4 + q); const bf16_t* pr = proj + t * NPROJ;
                a[q] = *(const u32x2*)(pr + PC_CC + c0); b[q] = *(const u32x2*)(pr + PC_CH + c0); g[q] = *(const u32x2*)(pr + PC_CB + c0);
                x1[q] = *(const u32x2*)(pr + PC_KROPE + i0); x2[q] = *(const u32x2*)(pr + PC_KROPE + 16 + i0);
                cs[q] = *(const f32x4*)(cosT + t * 16 + i0); sn[q] = *(const f32x4*)(sinT + t * 16 + i0); }
#pragma unroll
            for (int q = 0; q < 4; ++q) { const size_t t = (size_t)(t0 + tb4 + q);
                const f32x4 u = {bf_lo(a[q].x) * bf_lo(b[q].x), bf_hi(a[q].x) * bf_hi(b[q].x), bf_lo(a[q].y) * bf_lo(b[q].y), bf_hi(a[q].y) * bf_hi(b[q].y)};
                const f32x4 y = w0 * um2 + w1 * um1 + w2 * u;
                um2 = um1; um1 = u;
                *(u32x2*)(cc + t * D + 512 + c0) = (u32x2){pk2(bf_lo(g[q].x) * y.x, bf_hi(g[q].x) * y.y), pk2(bf_lo(g[q].y) * y.z, bf_hi(g[q].y) * y.w)};
                const f32x4 xa = {bf_lo(x1[q].x), bf_hi(x1[q].x), bf_lo(x1[q].y), bf_hi(x1[q].y)}, xb = {bf_lo(x2[q].x), bf_hi(x2[q].x), bf_lo(x2[q].y), bf_hi(x2[q].y)};
                const f32x4 o = half ? (xb * cs[q] + xa * sn[q]) : (xa * cs[q] - xb * sn[q]);
                *(u32x2*)(K + ((size_t)head * T + t) * 96 + 64 + 4 * part) = (u32x2){pk2(o.x, o.y), pk2(o.z, o.w)}; }
        }
    }
}

typedef __bf16 bf16x2v_t __attribute__((ext_vector_type(2)));
__device__ __forceinline__ unsigned cvtpk(float lo, float hi) { const f32x2_t v = {lo, hi}; const bf16x2v_t b = __builtin_convertvector(v, bf16x2v_t); return __builtin_bit_cast(unsigned, b); }
__device__ __forceinline__ float fexp2(float x) { return __builtin_amdgcn_exp2f(x); }
__device__ __forceinline__ float flog2(float x) { return __builtin_amdgcn_logf(x); }
constexpr int AK_PITCH = 208, AV_PITCH = 144;
constexpr int AK_BYTES = 64 * AK_PITCH, AV_BYTES = 64 * AV_PITCH;
constexpr int ATT_K0 = 0, ATT_V0 = 2 * AK_BYTES, ATT_LDS = 2 * AK_BYTES + 2 * AV_BYTES;
__device__ __forceinline__ int key_slot(int key) { return (key & ~12) | ((key & 4) << 1) | ((key & 8) >> 1); }
template <int DK> struct AttStage { u32x4 k0, k1, v; };
template <int DK> __device__ __forceinline__ void att_load(AttStage<DK>& st, const bf16_t* Kg, int kpitch, const bf16_t* Vg, int vpitch, int tid) {
    constexpr int KCH = DK / 8;
    { const int key = tid / KCH, part = tid % KCH; st.k0 = *(const u32x4*)(Kg + (size_t)key * kpitch + part * 8); }
    if (DK == 96) { if (tid < 256) { const int c = tid + 512, key = c / KCH, part = c % KCH; st.k1 = *(const u32x4*)(Kg + (size_t)key * kpitch + part * 8); } }
    { const int key = tid & 63, dch = tid >> 6; st.v = *(const u32x4*)(Vg + (size_t)key * vpitch + dch * 8); }
}
template <int DK> __device__ __forceinline__ void att_store(const AttStage<DK>& st, LAS unsigned char* kbuf, LAS unsigned char* vbuf, int tid) {
    constexpr int KCH = DK / 8;
    { const int key = tid / KCH, part = tid % KCH; *(LAS u32x4*)(kbuf + key * AK_PITCH + part * 16) = st.k0; }
    if (DK == 96) { if (tid < 256) { const int c = tid + 512, key = c / KCH, part = c % KCH; *(LAS u32x4*)(kbuf + key * AK_PITCH + part * 16) = st.k1; } }
    { const int key = tid & 63, dch = tid >> 6; LAS unsigned char* vp = vbuf + (dch * 8) * AV_PITCH + key_slot(key) * 2;
      const unsigned w0 = st.v.x, w1 = st.v.y, w2 = st.v.z, w3 = st.v.w;
      *(LAS bf16_t*)(vp + 0 * AV_PITCH) = (bf16_t)(w0 & 0xffffu); *(LAS bf16_t*)(vp + 1 * AV_PITCH) = (bf16_t)(w0 >> 16);
      *(LAS bf16_t*)(vp + 2 * AV_PITCH) = (bf16_t)(w1 & 0xffffu); *(LAS bf16_t*)(vp + 3 * AV_PITCH) = (bf16_t)(w1 >> 16);
      *(LAS bf16_t*)(vp + 4 * AV_PITCH) = (bf16_t)(w2 & 0xffffu); *(LAS bf16_t*)(vp + 5 * AV_PITCH) = (bf16_t)(w2 >> 16);
      *(LAS bf16_t*)(vp + 6 * AV_PITCH) = (bf16_t)(w3 & 0xffffu); *(LAS bf16_t*)(vp + 7 * AV_PITCH) = (bf16_t)(w3 >> 16); }
}
template <int DK> __device__ __forceinline__ void att_load_k(AttStage<DK>& st, const bf16_t* Kg, int kpitch, int tid) {
    constexpr int KCH = DK / 8;
    { const int key = tid / KCH, part = tid % KCH; st.k0 = *(const u32x4*)(Kg + (size_t)key * kpitch + part * 8); }
    if (DK == 96) { if (tid < 256) { const int c = tid + 512, key = c / KCH, part = c % KCH; st.k1 = *(const u32x4*)(Kg + (size_t)key * kpitch + part * 8); } }
}
__device__ __forceinline__ void att_load_kc(AttStage<96>& st, const bf16_t* Kg, int tid) {
    st.k0 = *(const u32x4*)(Kg + 8u * (unsigned)tid);
    if (tid < 256) st.k1 = *(const u32x4*)(Kg + 8u * (unsigned)(tid + 512));
}
template <int DK> __device__ __forceinline__ void att_load_v(AttStage<DK>& st, const bf16_t* Vg, int vpitch, int tid) {
    const unsigned key = (unsigned)tid & 63u, dch = (unsigned)tid >> 6; st.v = *(const u32x4*)(Vg + (key * (unsigned)vpitch + dch * 8u));
}
template <int DK> __device__ __forceinline__ void att_store_k(const AttStage<DK>& st, LAS unsigned char* kbuf, int tid) {
    constexpr int KCH = DK / 8;
    { const int key = tid / KCH, part = tid % KCH; *(LAS u32x4*)(kbuf + key * AK_PITCH + part * 16) = st.k0; }
    if (DK == 96) { if (tid < 256) { const int c = tid + 512, key = c / KCH, part = c % KCH; *(LAS u32x4*)(kbuf + key * AK_PITCH + part * 16) = st.k1; } }
}
template <int DK> __device__ __forceinline__ void att_store_v(const AttStage<DK>& st, LAS unsigned char* vbuf, int tid) {
    const int key = tid & 63, dch = tid >> 6; LAS unsigned char* vp = vbuf + (dch * 8) * AV_PITCH + key_slot(key) * 2;
    const unsigned w0 = st.v.x, w1 = st.v.y, w2 = st.v.z, w3 = st.v.w;
    *(LAS bf16_t*)(vp + 0 * AV_PITCH) = (bf16_t)(w0 & 0xffffu); *(LAS bf16_t*)(vp + 1 * AV_PITCH) = (bf16_t)(w0 >> 16);
    *(LAS bf16_t*)(vp + 2 * AV_PITCH) = (bf16_t)(w1 & 0xffffu); *(LAS bf16_t*)(vp + 3 * AV_PITCH) = (bf16_t)(w1 >> 16);
    *(LAS bf16_t*)(vp + 4 * AV_PITCH) = (bf16_t)(w2 & 0xffffu); *(LAS bf16_t*)(vp + 5 * AV_PITCH) = (bf16_t)(w2 >> 16);
    *(LAS bf16_t*)(vp + 6 * AV_PITCH) = (bf16_t)(w3 & 0xffffu); *(LAS bf16_t*)(vp + 7 * AV_PITCH) = (bf16_t)(w3 >> 16);
}
__device__ __forceinline__ bf16x8 pack8(const f32x16& p, int base) {
    u32x4 w; w.x = cvtpk(p[base + 0], p[base + 1]); w.y = cvtpk(p[base + 2], p[base + 3]); w.z = cvtpk(p[base + 4], p[base + 5]); w.w = cvtpk(p[base + 6], p[base + 7]);
    return __builtin_bit_cast(bf16x8, w);
}
__device__ __forceinline__ void att_write_out(bf16_t* orow, const f32x16& o0, const f32x16& o1, float scale, int hi) {
#pragma unroll
    for (int g = 0; g < 4; ++g) {
        *(u32x2*)(orow + 8 * g + 4 * hi) = (u32x2){cvtpk(o0[4 * g] * scale, o0[4 * g + 1] * scale), cvtpk(o0[4 * g + 2] * scale, o0[4 * g + 3] * scale)};
        *(u32x2*)(orow + 32 + 8 * g + 4 * hi) = (u32x2){cvtpk(o1[4 * g] * scale, o1[4 * g + 1] * scale), cvtpk(o1[4 * g + 2] * scale, o1[4 * g + 3] * scale)};
    }
}
#define ZERO16 (f32x16){0.f, 0.f, 0.f, 0.f, 0.f, 0.f, 0.f, 0.f, 0.f, 0.f, 0.f, 0.f, 0.f, 0.f, 0.f, 0.f}
__device__ __forceinline__ f32x16 zero16_opq() { float z; asm volatile("v_mov_b32 %0, 0" : "=v"(z)); return (f32x16){z, z, z, z, z, z, z, z, z, z, z, z, z, z, z, z}; }

#define SBAR() __builtin_amdgcn_sched_barrier(0)
#define PIN1(x) asm volatile("" : "+v"(x))
#define MFMA32(a, b, c) __builtin_amdgcn_mfma_f32_32x32x16_bf16(a, b, c, 0, 0, 0)
#define MLA_FA(X, B, W0, W1) { sa += X[B] + X[B + 1]; sb += X[B + 2] + X[B + 3]; W0 = cvtpk(X[B], X[B + 1]); W1 = cvtpk(X[B + 2], X[B + 3]); PIN1(sa); PIN1(sb); PIN1(W0); PIN1(W1); }
#define MLA_FB(X, B) { X[B] = fexp2(X[B] - m); X[B + 1] = fexp2(X[B + 1] - m); X[B + 2] = fexp2(X[B + 2] - m); X[B + 3] = fexp2(X[B + 3] - m); PIN1(X[B]); PIN1(X[B + 1]); PIN1(X[B + 2]); PIN1(X[B + 3]); }
#define MLA_ROWMAX(C0, C1, MX) { float mxa = fmaxf(fmaxf(C0[0], C0[1]), C1[0]), mxb = fmaxf(fmaxf(C0[2], C0[3]), C1[1]); mxa = fmaxf(fmaxf(mxa, C1[2]), C1[3]); \
        _Pragma("unroll") for (int r = 4; r < 16; r += 4) { mxa = fmaxf(fmaxf(mxa, C0[r]), C0[r + 1]); mxb = fmaxf(fmaxf(mxb, C0[r + 2]), C0[r + 3]); mxa = fmaxf(fmaxf(mxa, C1[r]), C1[r + 1]); mxb = fmaxf(fmaxf(mxb, C1[r + 2]), C1[r + 3]); } \
        MX = max_x32(fmaxf(mxa, mxb)); }
#define KA(S, H) (*(const LAS bf16x8*)(ka + 32 * (S) + (H) * 32 * AK_PITCH))
#define VA(S, H) (*(const LAS bf16x8*)(va + 32 * (S) + (H) * 32 * AV_PITCH))
#define MLA_PHASE_A(C0, C1, P0, P1, FILL) { \
        float sa = 0.f, sb = 0.f; \
        bf16x8 e0 = KA(0, 0), e1 = KA(0, 1); \
        C0 = MFMA32(e0, qf[0], ZERO16); e0 = KA(1, 0); if (FILL) MLA_FA(P0, 0, w[0], w[1]) SBAR(); C1 = MFMA32(e1, qf[0], ZERO16); e1 = KA(1, 1); if (FILL) MLA_FA(P0, 4, w[2], w[3]) SBAR(); \
        C0 = MFMA32(e0, qf[1], C0); e0 = KA(2, 0); if (FILL) MLA_FA(P0, 8, w[4], w[5]) SBAR(); C1 = MFMA32(e1, qf[1], C1); e1 = KA(2, 1); if (FILL) MLA_FA(P0, 12, w[6], w[7]) SBAR(); \
        C0 = MFMA32(e0, qf[2], C0); e0 = KA(3, 0); if (FILL) MLA_FA(P1, 0, w[8], w[9]) SBAR(); C1 = MFMA32(e1, qf[2], C1); e1 = KA(3, 1); if (FILL) MLA_FA(P1, 4, w[10], w[11]) SBAR(); \
        C0 = MFMA32(e0, qf[3], C0); e0 = KA(4, 0); if (FILL) MLA_FA(P1, 8, w[12], w[13]) SBAR(); C1 = MFMA32(e1, qf[3], C1); e1 = KA(4, 1); if (FILL) MLA_FA(P1, 12, w[14], w[15]) SBAR(); \
        C0 = MFMA32(e0, qf[4], C0); e0 = KA(5, 0); SBAR(); C1 = MFMA32(e1, qf[4], C1); e1 = KA(5, 1); SBAR(); \
        C0 = MFMA32(e0, qf[5], C0); SBAR(); C1 = MFMA32(e1, qf[5], C1); SBAR(); \
        if (FILL) l += sa + sb; }
#define MLA_WFRAG(i) __builtin_bit_cast(bf16x8, (u32x4){w[4 * (i)], w[4 * (i) + 1], w[4 * (i) + 2], w[4 * (i) + 3]})
#define MLA_PHASE_B(C0, C1, EXPS) { \
        bf16x8 e0 = VA(0, 0), e1 = VA(0, 1); \
        o0 = MFMA32(e0, MLA_WFRAG(0), o0); e0 = VA(1, 0); if (EXPS) MLA_FB(C0, 0) SBAR(); o1 = MFMA32(e1, MLA_WFRAG(0), o1); e1 = VA(1, 1); if (EXPS) MLA_FB(C0, 4) SBAR(); \
        o0 = MFMA32(e0, MLA_WFRAG(1), o0); e0 = VA(2, 0); if (EXPS) MLA_FB(C0, 8) SBAR(); o1 = MFMA32(e1, MLA_WFRAG(1), o1); e1 = VA(2, 1); if (EXPS) MLA_FB(C0, 12) SBAR(); \
        o0 = MFMA32(e0, MLA_WFRAG(2), o0); e0 = VA(3, 0); if (EXPS) MLA_FB(C1, 0) SBAR(); o1 = MFMA32(e1, MLA_WFRAG(2), o1); e1 = VA(3, 1); if (EXPS) MLA_FB(C1, 4) SBAR(); \
        o0 = MFMA32(e0, MLA_WFRAG(3), o0); if (EXPS) MLA_FB(C1, 8) SBAR(); o1 = MFMA32(e1, MLA_WFRAG(3), o1); if (EXPS) MLA_FB(C1, 12) SBAR(); }
#define MLA_STEP(C0, C1, P0, P1) { \
        const LAS unsigned char* ka = lds + ATT_K0 + (t & 1) * AK_BYTES + r32 * AK_PITCH + hi * 16; const LAS unsigned char* va = lds + ATT_V0 + ((t + 1) & 1) * AV_BYTES + r32 * AV_PITCH + hi * 16; \
        unsigned w[16]; \
        if (t == 0) {                         \
            MLA_PHASE_A(C0, C1, P0, P1, false) \
            float mx; MLA_ROWMAX(C0, C1, mx) m = mx; \
            _Pragma("unroll") for (int r = 0; r < 16; ++r) { C0[r] = fexp2(C0[r] - m); C1[r] = fexp2(C1[r] - m); } \
        } else if (t <= my_last) {            \
            MLA_PHASE_A(C0, C1, P0, P1, true) \
            float mx; MLA_ROWMAX(C0, C1, mx) \
            float alpha = 1.0f; bool resc = false; \
            if (__builtin_expect(__any(mx > m), 0)) { const float mn = fmaxf(m, mx); alpha = fexp2(m - mn); m = mn; l *= alpha; resc = true; }     \
            MLA_PHASE_B(C0, C1, true) \
            if (resc) { o0 *= alpha; o1 *= alpha; } \
        } else if (t == my_last + 1) {        \
            float sa = 0.f, sb = 0.f; \
            MLA_FA(P0, 0, w[0], w[1]) MLA_FA(P0, 4, w[2], w[3]) MLA_FA(P0, 8, w[4], w[5]) MLA_FA(P0, 12, w[6], w[7]) MLA_FA(P1, 0, w[8], w[9]) MLA_FA(P1, 4, w[10], w[11]) MLA_FA(P1, 8, w[12], w[13]) MLA_FA(P1, 12, w[14], w[15]) \
            l += sa + sb; \
            MLA_PHASE_B(C0, C1, false) \
        } }
__device__ __forceinline__ void phase_mla(KParams p, LAS unsigned char* lds, int bid, int nb, int wid_s) {
    const int tid = opaque_tid(wid_s), lane = tid & 63, wave = __builtin_amdgcn_readfirstlane(tid >> 6), r32 = lane & 31, hi = lane >> 5;
    const bf16_t* Q = (const bf16_t*)((unsigned char*)p->out + OUT_Q); const bf16_t* K = (const bf16_t*)((unsigned char*)p->out + OUT_K); const bf16_t* V = (const bf16_t*)((unsigned char*)p->out + OUT_V);
    bf16_t* cc = (bf16_t*)(p->ws + WS_CONCAT);
    for (int u = bid; u < 1024; u += nb) {
        const int slot = (u >> 8) & 3, ub = u & 255, v = (((ub & 7) * 16 + (ub >> 4)) << 1) | ((ub >> 3) & 1), bh = v >> 1, b = bh >> 3, h = bh & 7;
        const int qb = (v & 1) ? ((slot == 0) ? 6 : (slot == 1) ? 1 : (slot == 2) ? 5 : 2) : ((slot == 0) ? 7 : (slot == 1) ? 0 : (slot == 2) ? 4 : 3);
        const int q0 = qb * 256, nt = 4 * qb + 4, my_last = (q0 + 32 * wave) >> 6;
        const bf16_t* Kg = K + ((size_t)h * T + b * SEQ) * 96; const bf16_t* Vg = V + ((size_t)h * T + b * SEQ) * 64;
        const bf16_t* qrow = Q + (unsigned)((h * T + b * SEQ + q0 + 32 * wave + r32) * 96 + hi * 8);
        bf16x8 qf[6];
#pragma unroll
        for (int s = 0; s < 6; ++s) qf[s] = *(const bf16x8*)(qrow + 16 * s);
        f32x16 o0 = zero16_opq(), o1 = o0, pA0, pA1, pB0, pB1; float m = -1.0e30f, l = 0.f;
        AttStage<96> st;
        att_load_kc(st, Kg, tid);
        att_store_k<96>(st, lds + ATT_K0, tid);
        __syncthreads();
#define MLA_TILE(TT, C0, C1, P0, P1) { const int t = (TT); \
            {   const int tk = t + 1 < nt ? t + 1 : nt - 1, tv = t < nt ? t : nt - 1;     \
                att_load_kc(st, Kg + (size_t)tk * 64 * 96, tid); st.v = *(const u32x4*)(Vg + (size_t)tv * 64 * 64 + 8u * (unsigned)tid); } \
            MLA_STEP(C0, C1, P0, P1) \
            att_store_k<96>(st, lds + ATT_K0 + ((t + 1) & 1) * AK_BYTES, tid); \
            att_store_v<96>(st, lds + ATT_V0 + (t & 1) * AV_BYTES, tid); \
            __syncthreads(); }
        for (int tt = 0; tt <= nt; tt += 2) {
            MLA_TILE(tt, pA0, pA1, pB0, pB1)
            if (tt < nt) MLA_TILE(tt + 1, pB0, pB1, pA0, pA1)
        }
#undef MLA_TILE
        l = sum_x32(l);
        att_write_out(cc + (size_t)(b * SEQ + q0 + 32 * wave + r32) * D + h * 64, o0, o1, 1.0f / l, hi);
    }
}
#undef MLA_STEP
#undef MLA_PHASE_A
#undef MLA_PHASE_B
#undef MLA_FA
#undef MLA_FB
#undef MLA_WFRAG
#undef MLA_ROWMAX
#undef KA
#undef VA

__device__ __forceinline__ bool sb_iter(int it, int nt, int my_first, int qpos, const bf16x8 (&qf)[4], const bf16x8 (&U)[2][4], f32x16& o0, f32x16& o1, float& carry, AttStage<64>& st,
                                        const bf16_t* Kg, const bf16_t* Vg, LAS unsigned char* lds, int tid, int lane, int wave, int r32, int hi) {
            const int t = nt - 1 - it;
            LAS unsigned char* kbuf = lds + ATT_K0 + (it & 1) * AK_BYTES; LAS unsigned char* vbuf = lds + ATT_V0 + (it & 1) * AV_BYTES;
            if (t > 0) att_load<64>(st, Kg + (size_t)(t - 1) * 64 * SBX_PITCH, SBX_PITCH, Vg + (size_t)(t - 1) * 64 * SBX_PITCH, SBX_PITCH, tid);
            if (t <= my_first) {
                f32x16 z0 = ZERO16, z1 = ZERO16;
                const LAS unsigned char* ka = kbuf + r32 * AK_PITCH + hi * 16;
#pragma unroll
                for (int s = 0; s < 4; ++s) {
                    const bf16x8 a0 = *(const LAS bf16x8*)(ka + 32 * s), a1 = *(const LAS bf16x8*)(ka + 32 * AK_PITCH + 32 * s);
                    z0 = __builtin_amdgcn_mfma_f32_32x32x16_bf16(a0, qf[s], z0, 0, 0, 0); z1 = __builtin_amdgcn_mfma_f32_32x32x16_bf16(a1, qf[s], z1, 0, 0, 0);
                }
                if (t == my_first) {
                    const int kb0 = t * 64 + 4 * hi;
#pragma unroll
                    for (int r = 0; r < 16; ++r) { const int kk = kb0 + (r & 3) + 8 * (r >> 2); z0[r] = (kk < qpos) ? z0[r] : -30000.0f; z1[r] = ((kk + 32) < qpos) ? z1[r] : -30000.0f; }
                }
                f32x16 m0, m1; float tot = 0.f;
#pragma unroll
                for (int r = 0; r < 16; ++r) {
                    { const float z = z0[r], e = fexp2(-fabsf(z)), ls = fminf(z, 0.f) - flog2(1.0f + e); z0[r] = ls; m0[r] = ls - z; tot += m0[r]; }
                    { const float z = z1[r], e = fexp2(-fabsf(z)), ls = fminf(z, 0.f) - flog2(1.0f + e); z1[r] = ls; m1[r] = ls - z; tot += m1[r]; }
                }
                tot = sum_x32(tot);
                const bf16x8 lf0 = pack8(m0, 0), lf1 = pack8(m0, 8), lf2 = pack8(m1, 0), lf3 = pack8(m1, 8);
                f32x16 c0 = ZERO16, c1 = ZERO16;
                c0 = __builtin_amdgcn_mfma_f32_32x32x16_bf16(U[0][0], lf0, c0, 0, 0, 0); c1 = __builtin_amdgcn_mfma_f32_32x32x16_bf16(U[1][0], lf0, c1, 0, 0, 0);
                c0 = __builtin_amdgcn_mfma_f32_32x32x16_bf16(U[0][1], lf1, c0, 0, 0, 0); c1 = __builtin_amdgcn_mfma_f32_32x32x16_bf16(U[1][1], lf1, c1, 0, 0, 0);
                c0 = __builtin_amdgcn_mfma_f32_32x32x16_bf16(U[0][2], lf2, c0, 0, 0, 0); c1 = __builtin_amdgcn_mfma_f32_32x32x16_bf16(U[1][2], lf2, c1, 0, 0, 0);
                c0 = __builtin_amdgcn_mfma_f32_32x32x16_bf16(U[0][3], lf3, c0, 0, 0, 0); c1 = __builtin_amdgcn_mfma_f32_32x32x16_bf16(U[1][3], lf3, c1, 0, 0, 0);
#pragma unroll
                for (int r = 0; r < 16; ++r) { z0[r] = fexp2(z0[r] + (carry + c0[r])); z1[r] = fexp2(z1[r] + (carry + c1[r])); }
                carry += tot;
                const bf16x8 wf0 = pack8(z0, 0), wf1 = pack8(z0, 8), wf2 = pack8(z1, 0), wf3 = pack8(z1, 8);
                const LAS unsigned char* va = vbuf + r32 * AV_PITCH + hi * 16;
#define SB_PV(S, PF) { const bf16x8 v0 = *(const LAS bf16x8*)(va + 32 * (S)), v1 = *(const LAS bf16x8*)(va + 32 * AV_PITCH + 32 * (S)); \
                       o0 = __builtin_amdgcn_mfma_f32_32x32x16_bf16(v0, PF, o0, 0, 0, 0); o1 = __builtin_amdgcn_mfma_f32_32x32x16_bf16(v1, PF, o1, 0, 0, 0); }
                SB_PV(0, wf0) SB_PV(1, wf1) SB_PV(2, wf2) SB_PV(3, wf3)
#undef SB_PV
            }
            if (t > 0) att_store<64>(st, lds + ATT_K0 + ((it + 1) & 1) * AK_BYTES, lds + ATT_V0 + ((it + 1) & 1) * AV_BYTES, tid);
            LAS int* flg = (LAS int*)(lds + ATT_LDS) + (it & 1) * 8;
            { const int mine = __all((t <= my_first && carry < -173.12f) ? 1 : 0); if (lane == 0) flg[wave] = mine; }
            __syncthreads();
            int done; { const LAS int* f = flg; done = f[0] & f[1] & f[2] & f[3] & f[4] & f[5] & f[6] & f[7]; }
            return done != 0;
}
__device__ __forceinline__ void phase_sb(KParams p, LAS unsigned char* lds, int bid, int nb, int wid_s) {
    const int tid = opaque_tid(wid_s), lane = tid & 63, wave = __builtin_amdgcn_readfirstlane(tid >> 6), r32 = lane & 31, hi = lane >> 5;
    bf16_t* cc = (bf16_t*)(p->ws + WS_CONCAT);
    bf16x8 U[2][4];
#pragma unroll
    for (int kbo = 0; kbo < 2; ++kbo)
#pragma unroll
        for (int s = 0; s < 4; ++s) {
            bf16x8 f;
#pragma unroll
            for (int j = 0; j < 8; ++j) f[j] = ((16 * s + 8 * (j >> 2) + 4 * hi + (j & 3)) > (32 * kbo + r32)) ? (short)0x3F80 : (short)0;
            U[kbo][s] = f;
        }
    for (int u = bid; u < 512; u += nb) {
        const int slot = (u >> 8) & 1, ub = u & 255, v = (((ub & 7) * 8 + (ub >> 5)) << 2) | ((ub >> 3) & 3), bh = v >> 2, b = bh >> 2, h = bh & 3, sidx = v & 3, qb = slot ? sidx : 7 - sidx;
        const int q0 = qb * 256, nt = 4 * qb + 4, my_first = (q0 + 32 * wave) >> 6, qpos = q0 + 32 * wave + r32;
        const bf16_t* sbx = (const bf16_t*)(p->ws + WS_SBX);
        const bf16_t* Kg = sbx + (size_t)(b * SEQ) * SBX_PITCH + 256 + h * 64; const bf16_t* Vg = sbx + (size_t)(b * SEQ) * SBX_PITCH + 512 + h * 64;
        const bf16_t* qrow = sbx + (size_t)(b * SEQ + qpos) * SBX_PITCH + h * 64 + hi * 8;
        bf16x8 qf[4];
#pragma unroll
        for (int s = 0; s < 4; ++s) { const u32x4 w = *(const u32x4*)(qrow + 16 * s);
            qf[s] = __builtin_bit_cast(bf16x8, (u32x4){pk2(bf_lo(w.x) * SBQ_SCALE, bf_hi(w.x) * SBQ_SCALE), pk2(bf_lo(w.y) * SBQ_SCALE, bf_hi(w.y) * SBQ_SCALE), pk2(bf_lo(w.z) * SBQ_SCALE, bf_hi(w.z) * SBQ_SCALE), pk2(bf_lo(w.w) * SBQ_SCALE, bf_hi(w.w) * SBQ_SCALE)}); }
        f32x16 o0 = ZERO16, o1 = ZERO16; float carry = 0.f;
        AttStage<64> stA;
        att_load<64>(stA, Kg + (size_t)(nt - 1) * 64 * SBX_PITCH, SBX_PITCH, Vg + (size_t)(nt - 1) * 64 * SBX_PITCH, SBX_PITCH, tid);
        att_store<64>(stA, lds + ATT_K0, lds + ATT_V0, tid);
        __syncthreads();
        for (int it = 0; it < nt; it += 2) {
            if (sb_iter(it, nt, my_first, qpos, qf, U, o0, o1, carry, stA, Kg, Vg, lds, tid, lane, wave, r32, hi)) break;
            if (sb_iter(it + 1, nt, my_first, qpos, qf, U, o0, o1, carry, stA, Kg, Vg, lds, tid, lane, wave, r32, hi)) break;
        }
        __syncthreads();
        att_write_out(cc + (size_t)(b * SEQ + qpos) * D + 768 + h * 64, o0, o1, 1.0f, hi);
    }
}

#define CE(a, b) { const float hi_ = vmaxf(a, b), lo_ = vminf(a, b); a = hi_; b = lo_; }
__device__ __forceinline__ void sort16_desc(float (&x)[16]) { CE(x[0], x[1]) CE(x[2], x[3]) CE(x[0], x[2]) CE(x[1], x[3]) CE(x[1], x[2]) CE(x[4], x[5]) CE(x[6], x[7]) CE(x[4], x[6]) CE(x[5], x[7]) CE(x[5], x[6]) CE(x[0], x[4]) CE(x[2], x[6]) CE(x[2], x[4]) CE(x[1], x[5]) CE(x[3], x[7]) CE(x[3], x[5]) CE(x[1], x[2]) CE(x[3], x[4]) CE(x[5], x[6]) CE(x[8], x[9]) CE(x[10], x[11]) CE(x[8], x[10]) CE(x[9], x[11]) CE(x[9], x[10]) CE(x[12], x[13]) CE(x[14], x[15]) CE(x[12], x[14]) CE(x[13], x[15]) CE(x[13], x[14]) CE(x[8], x[12]) CE(x[10], x[14]) CE(x[10], x[12]) CE(x[9], x[13]) CE(x[11], x[15]) CE(x[11], x[13]) CE(x[9], x[10]) CE(x[11], x[12]) CE(x[13], x[14]) CE(x[0], x[8]) CE(x[4], x[12]) CE(x[4], x[8]) CE(x[2], x[10]) CE(x[6], x[14]) CE(x[6], x[10]) CE(x[2], x[4]) CE(x[6], x[8]) CE(x[10], x[12]) CE(x[1], x[9]) CE(x[5], x[13]) CE(x[5], x[9]) CE(x[3], x[11]) CE(x[7], x[15]) CE(x[7], x[11]) CE(x[3], x[5]) CE(x[7], x[9]) CE(x[11], x[13]) CE(x[1], x[2]) CE(x[3], x[4]) CE(x[5], x[6]) CE(x[7], x[8]) CE(x[9], x[10]) CE(x[11], x[12]) CE(x[13], x[14]) }
__device__ __forceinline__ void bitonic_sort16_desc(float (&M)[16]) {
#pragma unroll
    for (int dlt = 8; dlt >= 1; dlt >>= 1)
#pragma unroll
        for (int i = 0; i < 16; ++i) if ((i & dlt) == 0) CE(M[i], M[i + dlt])
}
__device__ __forceinline__ void merge_top16(float (&R)[16], const float (&S)[16]) {
#pragma unroll
    for (int i = 0; i < 16; ++i) R[i] = vmaxf(R[i], S[15 - i]);
    bitonic_sort16_desc(R);
}
constexpr int TK_KPITCH = 272, TK_KBYTES = 2 * 128 * TK_KPITCH, TK_LV = TK_KBYTES;
__device__ __forceinline__ void phase_topk(KParams p, int l, LAS unsigned char* lds, int bid, int nb, int wid_s) {
    const int tidx = opaque_tid(wid_s);
    const int tid = tidx, lane = tid & 63, wave = tid >> 6, r32 = lane & 31, hi = lane >> 5;
    LAS float* LV = (LAS float*)(lds + TK_LV);
    const bf16_t* PQ = (const bf16_t*)(p->ws + WS_PQ);
    const bf16_t* K1 = (const bf16_t*)(p->ws + WS_K1) + (size_t)l * 8 * 128 * 128; const bf16_t* K2 = (const bf16_t*)(p->ws + WS_K2) + (size_t)l * 8 * 128 * 128;
    int* IDX = (int*)(p->ws + WS_IDX); float* GATE = (float*)(p->ws + WS_GATE);
    int staged_head = -1;
    for (int item = bid; item < (T / 512) * 8; item += nb) {
        const int head = item & 7, tt = item >> 3;
        if (head != staged_head) {
            __syncthreads();
            for (int ch = tid; ch < 2 * 128 * 16; ch += NTHR) { const int half = ch >> 11, row = (ch >> 4) & 127, c16 = ch & 15;
                const u32x4 v = *(const u32x4*)((half ? K2 : K1) + ((size_t)head * 128 + row) * 128 + c16 * 8);
                *(LAS u32x4*)(lds + (half * 128 + row) * TK_KPITCH + c16 * 16) = v; }
            staged_head = head;
            __syncthreads();
        }
        bf16x8 qn[8];
        {   const int half = wave & 1, st = wave >> 1; const bf16_t* qrow = PQ + ((((size_t)head * (T / 32) + (tt * 16 + st)) * 2 + half) * 8) * 512 + lane * 8;
#pragma unroll
            for (int s = 0; s < 8; ++s) qn[s] = *(const bf16x8*)(qrow + 512 * s); }
        for (int task = wave; task < 32; task += 8) {
            const int half = task & 1, st = task >> 1;
            bf16x8 qf[8];
#pragma unroll
            for (int s = 0; s < 8; ++s) qf[s] = qn[s];
            if (task + 8 < 32) { const int t2 = task + 8, half2 = t2 & 1, st2 = t2 >> 1; const bf16_t* qrow = PQ + ((((size_t)head * (T / 32) + (tt * 16 + st2)) * 2 + half2) * 8) * 512 + lane * 8;
#pragma unroll
                for (int s = 0; s < 8; ++s) qn[s] = *(const bf16x8*)(qrow + 512 * s); }
            const LAS unsigned char* kbase = lds + (half * 128 + r32) * TK_KPITCH + hi * 16;
            float Lst[16];
#pragma unroll
            for (int kb = 0; kb < 4; ++kb) {
                f32x16 acc = {0.f, 0.f, 0.f, 0.f, 0.f, 0.f, 0.f, 0.f, 0.f, 0.f, 0.f, 0.f, 0.f, 0.f, 0.f, 0.f};
#pragma unroll
                for (int s = 0; s < 8; ++s) { const bf16x8 kf = *(const LAS bf16x8*)(kbase + kb * 32 * TK_KPITCH + 32 * s); acc = __builtin_amdgcn_mfma_f32_32x32x16_bf16(kf, qf[s], acc, 0, 0, 0); }
                float x[16];
#pragma unroll
                for (int r = 0; r < 16; ++r) {
                    const int key = kb * 32 + (r & 3) + 8 * (r >> 2) + 4 * hi;
                    const float av = acc[r];
                    x[r] = __uint_as_float((__float_as_uint(av) & 0xffffff80u) | (unsigned)key);
                }
                sort16_desc(x);
                if (kb == 0) {
#pragma unroll
                    for (int r = 0; r < 16; ++r) Lst[r] = x[r];
                } else merge_top16(Lst, x);
            }
            float M[16];
#pragma unroll
            for (int i = 0; i < 16; ++i) { float a = Lst[15 - i], b = Lst[i]; swap32(a, b); M[i] = vmaxf(Lst[i], b); }
            bitonic_sort16_desc(M);
            if (hi == 0) {
                LAS float* dst = LV + ((size_t)(half * 512 + st * 32 + r32)) * 16;
#pragma unroll
                for (int i = 0; i < 16; i += 4) *(LAS f32x4*)(dst + i) = (f32x4){M[i], M[i + 1], M[i + 2], M[i + 3]};
            }
        }
        __syncthreads();
        {
            const int tok = tid, t = tt * 512 + tok;
            const LAS float* a1 = LV + (size_t)tok * 16; const LAS float* a2 = LV + (size_t)(512 + tok) * 16;
            float v1[16], v2[16];
#pragma unroll
            for (int i = 0; i < 16; i += 4) { const f32x4 x = *(const LAS f32x4*)(a1 + i), y = *(const LAS f32x4*)(a2 + i); v1[i] = x.x; v1[i + 1] = x.y; v1[i + 2] = x.z; v1[i + 3] = x.w; v2[i] = y.x; v2[i + 1] = y.y; v2[i + 2] = y.z; v2[i + 3] = y.w; }
            float Tt[16]; { OPQF(NEG, -3.0e38f);
#pragma unroll
            for (int i = 0; i < 16; ++i) Tt[i] = NEG; }
#pragma unroll
            for (int i = 0; i < 16; ++i)
#pragma unroll
                for (int j = 0; j < 16; ++j) if ((i + 1) * (j + 1) <= 16) {
                    const float sum = v1[i] + v2[j];
                    float xx = __builtin_bit_cast(float, (__builtin_bit_cast(unsigned, sum) & 0xffffff00u) | (unsigned)(i * 16 + j));
#pragma unroll
                    for (int lv = (i + 1) * (j + 1) - 1; lv < 16; ++lv) { const float hi_ = vmaxf(Tt[lv], xx); xx = vminf(Tt[lv], xx); Tt[lv] = hi_; }
                }
            float e[16], den = 0.f;
#pragma unroll
            for (int k = 0; k < 16; ++k) { e[k] = __expf(Tt[k] - Tt[0]); den += e[k]; }
            const float inv = 1.0f / den;
            int ex[16];
#pragma unroll
            for (int k = 0; k < 16; ++k) {
                const unsigned pos = __builtin_bit_cast(unsigned, Tt[k]) & 0xffu;
                const unsigned i1 = __builtin_bit_cast(unsigned, a1[pos >> 4]) & 0x7fu, i2 = __builtin_bit_cast(unsigned, a2[pos & 15]) & 0x7fu;
                ex[k] = (int)(i1 * 128u + i2);
            }
            int* ip = IDX + (size_t)t * 128 + head * 16; float* gp = GATE + (size_t)t * 128 + head * 16;
#pragma unroll
            for (int k = 0; k < 16; k += 4) { *(u32x4*)(ip + k) = (u32x4){(unsigned)ex[k], (unsigned)ex[k + 1], (unsigned)ex[k + 2], (unsigned)ex[k + 3]}; *(f32x4*)(gp + k) = (f32x4){e[k] * inv, e[k + 1] * inv, e[k + 2] * inv, e[k + 3] * inv}; }
        }
        __syncthreads();
    }
}

__device__ __forceinline__ void rowc_load_f32(const float* row, int lane, float (&v)[16]) {
    const f32x4 a = *(const f32x4*)(row + 16 * lane), b = *(const f32x4*)(row + 16 * lane + 4), c = *(const f32x4*)(row + 16 * lane + 8), d = *(const f32x4*)(row + 16 * lane + 12);
    v[0] = a.x; v[1] = a.y; v[2] = a.z; v[3] = a.w; v[4] = b.x; v[5] = b.y; v[6] = b.z; v[7] = b.w;
    v[8] = c.x; v[9] = c.y; v[10] = c.z; v[11] = c.w; v[12] = d.x; v[13] = d.y; v[14] = d.z; v[15] = d.w;
}
__device__ __forceinline__ void rowc_load_bf16(const bf16_t* row, int lane, float (&v)[16]) {
    const u32x4 a = *(const u32x4*)(row + 16 * lane), b = *(const u32x4*)(row + 16 * lane + 8);
    v[0] = bf_lo(a.x); v[1] = bf_hi(a.x); v[2] = bf_lo(a.y); v[3] = bf_hi(a.y); v[4] = bf_lo(a.z); v[5] = bf_hi(a.z); v[6] = bf_lo(a.w); v[7] = bf_hi(a.w);
    v[8] = bf_lo(b.x); v[9] = bf_hi(b.x); v[10] = bf_lo(b.y); v[11] = bf_hi(b.y); v[12] = bf_lo(b.z); v[13] = bf_hi(b.z); v[14] = bf_lo(b.w); v[15] = bf_hi(b.w);
}
__device__ __forceinline__ void rowc_store_f32(float* row, int lane, const float (&v)[16]) {
    *(f32x4*)(row + 16 * lane) = (f32x4){v[0], v[1], v[2], v[3]}; *(f32x4*)(row + 16 * lane + 4) = (f32x4){v[4], v[5], v[6], v[7]};
    *(f32x4*)(row + 16 * lane + 8) = (f32x4){v[8], v[9], v[10], v[11]}; *(f32x4*)(row + 16 * lane + 12) = (f32x4){v[12], v[13], v[14], v[15]};
}
__device__ __forceinline__ void rowc_store_bf16(bf16_t* row, int lane, const float (&v)[16]) {
    *(u32x4*)(row + 16 * lane) = (u32x4){pk2(v[0], v[1]), pk2(v[2], v[3]), pk2(v[4], v[5]), pk2(v[6], v[7])};
    *(u32x4*)(row + 16 * lane + 8) = (u32x4){pk2(v[8], v[9]), pk2(v[10], v[11]), pk2(v[12], v[13]), pk2(v[14], v[15])};
}
__device__ __forceinline__ void vdot_group(int (&Lo)[16], int (&By)[16], u32x4 w0, u32x4 w1, u32x4 w2, u32x4 w3, unsigned C) {
#define VD(d, X) { const unsigned p01l = __builtin_amdgcn_perm(w1.X, w0.X, 0x05010400u), p01h = __builtin_amdgcn_perm(w1.X, w0.X, 0x07030602u); \
                   const unsigned p23l = __builtin_amdgcn_perm(w3.X, w2.X, 0x05010400u), p23h = __builtin_amdgcn_perm(w3.X, w2.X, 0x07030602u); \
                   const unsigned t0 = __builtin_amdgcn_perm(p23l, p01l, 0x05040100u), t1 = __builtin_amdgcn_perm(p23l, p01l, 0x07060302u); \
                   const unsigned t2 = __builtin_amdgcn_perm(p23h, p01h, 0x05040100u), t3 = __builtin_amdgcn_perm(p23h, p01h, 0x07060302u); \
                   Lo[4 * d] = __builtin_amdgcn_sdot4((int)(t0 & 0x0F0F0F0Fu), (int)C, Lo[4 * d], false); By[4 * d] = __builtin_amdgcn_sdot4((int)t0, (int)C, By[4 * d], false); \
                   Lo[4 * d + 1] = __builtin_amdgcn_sdot4((int)(t1 & 0x0F0F0F0Fu), (int)C, Lo[4 * d + 1], false); By[4 * d + 1] = __builtin_amdgcn_sdot4((int)t1, (int)C, By[4 * d + 1], false); \
                   Lo[4 * d + 2] = __builtin_amdgcn_sdot4((int)(t2 & 0x0F0F0F0Fu), (int)C, Lo[4 * d + 2], false); By[4 * d + 2] = __builtin_amdgcn_sdot4((int)t2, (int)C, By[4 * d + 2], false); \
                   Lo[4 * d + 3] = __builtin_amdgcn_sdot4((int)(t3 & 0x0F0F0F0Fu), (int)C, Lo[4 * d + 3], false); By[4 * d + 3] = __builtin_amdgcn_sdot4((int)t3, (int)C, By[4 * d + 3], false); }
    VD(0, x) VD(1, y) VD(2, z) VD(3, w)
#undef VD
}
__device__ __forceinline__ void swap32i(int& a, int& b) { const auto r = __builtin_amdgcn_permlane32_swap((unsigned)a, (unsigned)b, false, false); a = (int)r[0]; b = (int)r[1]; }
__device__ __forceinline__ void swap16i(int& a, int& b) { const auto r = __builtin_amdgcn_permlane16_swap((unsigned)a, (unsigned)b, false, false); a = (int)r[0]; b = (int)r[1]; }
__device__ __forceinline__ int dot32_i4(u32x4 w, u32x4 A, u32x4 B) {
    int a = __builtin_amdgcn_sdot8((int)w.x, (int)A.x, 0, false); a = __builtin_amdgcn_sdot8((int)w.y, (int)A.y, a, false); a = __builtin_amdgcn_sdot8((int)w.z, (int)A.z, a, false); a = __builtin_amdgcn_sdot8((int)w.w, (int)A.w, a, false);
    int b = __builtin_amdgcn_sdot8((int)w.x, (int)B.x, 0, false); b = __builtin_amdgcn_sdot8((int)w.y, (int)B.y, b, false); b = __builtin_amdgcn_sdot8((int)w.z, (int)B.z, b, false); b = __builtin_amdgcn_sdot8((int)w.w, (int)B.w, b, false);
    return a * 16 + b;
}
__device__ __forceinline__ void phase_experts(KParams p, int l, bool last, LAS unsigned char* lds, int bid, int nb, int wid_s) {
    const int tidx = opaque_tid(wid_s);
    const int lane = tidx & 63, wave = __builtin_amdgcn_readfirstlane(tidx >> 6), j = lane >> 3, c = lane & 7, gw = bid * 8 + wave, ngw = nb * 8;
    const unsigned char* H2Q = p->ws + WS_H2Q; const float* HQS = (const float*)(p->ws + WS_HQS);
    const unsigned char* UB = p->ws + WS_UB + (size_t)l * TAB4_LAYER; const unsigned char* VB = p->ws + WS_VB + (size_t)l * TAB4_LAYER;
    const int* IDX = (const int*)(p->ws + WS_IDX); const float* GATE = (const float*)(p->ws + WS_GATE);
    const float* mod = (const float*)(p->ws + WS_MOD);
    bf16_t* OUTF = (bf16_t*)(p->ws + WS_PQ);
    const bf16_t* X1 = x1_buffer(p, l); float* XO = p->out; bf16_t* X2B = (bf16_t*)(p->ws + WS_X2); bf16_t* H1 = (bf16_t*)(p->ws + WS_H1);
    LAS float* cf = (LAS float*)(lds + wave * 16384);
    LAS int* ix = (LAS int*)(lds + wave * 16384 + 8192);
    for (int tb = 16 * gw; tb < T; tb += 16 * ngw) {
        for (int i = 0; i < 16; ++i) { int t = tb + i; t = t < T ? t : T - 1;
            const int k0 = lane, k1 = lane + 64;
            ix[i * 128 + (k0 & 7) * 16 + (k0 >> 3)] = IDX[(size_t)t * 128 + k0]; ix[i * 128 + (k1 & 7) * 16 + (k1 >> 3)] = IDX[(size_t)t * 128 + k1]; }
        asm volatile("s_waitcnt vmcnt(0) lgkmcnt(0)" ::: "memory");
        const unsigned offc = 16u * (unsigned)c;
#define ALOAD(dst, voff, sbase) asm volatile("global_load_dwordx4 %0, %1, %2" : "=v"(dst) : "v"(voff), "s"(sbase) : "memory")
#define ALOADO(dst, voff, sbase, O) asm volatile("global_load_dwordx4 %0, %1, %2 offset:" #O : "=v"(dst) : "v"(voff), "s"(sbase) : "memory")
#define ALOADT(dst, voff, sbase) asm volatile("global_load_dwordx4 %0, %1, %2" : "+v"(dst) : "v"(voff), "s"(sbase) : "memory")
#define ALOADOT(dst, voff, sbase, O) asm volatile("global_load_dwordx4 %0, %1, %2 offset:" #O : "+v"(dst) : "v"(voff), "s"(sbase) : "memory")
#define AWAIT8(N, W) asm volatile("s_waitcnt vmcnt(" #N ")" : "+v"(W[0]), "+v"(W[1]), "+v"(W[2]), "+v"(W[3]), "+v"(W[4]), "+v"(W[5]), "+v"(W[6]), "+v"(W[7]) :: "memory")
#define ISSUE8(W, base, ea, eb) { ALOAD(W[0], (ea).x * 128u + offc, base); ALOAD(W[1], (ea).y * 128u + offc, base); ALOAD(W[2], (ea).z * 128u + offc, base); ALOAD(W[3], (ea).w * 128u + offc, base); \
                                    ALOAD(W[4], (eb).x * 128u + offc, base); ALOAD(W[5], (eb).y * 128u + offc, base); ALOAD(W[6], (eb).z * 128u + offc, base); ALOAD(W[7], (eb).w * 128u + offc, base); }
        {
            u32x4 wa[8], wb[8], hA, hB;
            const unsigned hoff = 32u * (unsigned)c;
            {   int t0 = tb < T ? tb : T - 1; const unsigned char* hb = H2Q + (size_t)t0 * 1024; const unsigned char* Ub0 = UB;
                const LAS u32x4* ie = (const LAS u32x4*)(ix + j * 16); const u32x4 e0 = ie[0], e1 = ie[1], e2 = ie[2], e3 = ie[3];
                ALOAD(hA, hoff, hb); ALOADO(hB, hoff, hb, 16); ISSUE8(wa, Ub0, e0, e1) ISSUE8(wb, Ub0, e2, e3) }
#pragma unroll 1
            for (int r = 0; r < 64; ++r) {
                const int cb = r >> 4, i = r & 15, t = tb + i;
                const int r2 = r < 63 ? r + 1 : 63, cb2 = r2 >> 4, i2 = r2 & 15; int t2 = tb + i2; t2 = t2 < T ? t2 : T - 1;
                const unsigned char* Ub2 = UB + (size_t)cb2 * NEXP * 128; const unsigned char* hb2 = H2Q + (size_t)t2 * 1024 + 256 * cb2;
                const LAS u32x4* ie2 = (const LAS u32x4*)(ix + i2 * 128 + j * 16); const u32x4 f0 = ie2[0], f1 = ie2[1], f2 = ie2[2], f3 = ie2[3];
                asm volatile("s_waitcnt vmcnt(8)" : "+v"(hA), "+v"(hB), "+v"(wa[0]), "+v"(wa[1]), "+v"(wa[2]), "+v"(wa[3]), "+v"(wa[4]), "+v"(wa[5]), "+v"(wa[6]), "+v"(wa[7]) :: "memory");
                u32x4 cA = hA, cB = hB; asm volatile("" : "+v"(cA), "+v"(cB));
                int pd[16];
#pragma unroll
                for (int m = 0; m < 8; ++m) pd[m] = dot32_i4(wa[m], cA, cB);
                asm volatile("" : "+v"(pd[0]), "+v"(pd[1]), "+v"(pd[2]), "+v"(pd[3]), "+v"(pd[4]), "+v"(pd[5]), "+v"(pd[6]), "+v"(pd[7]) :: "memory");
                ALOADT(hA, hoff, hb2); ALOADOT(hB, hoff, hb2, 16); ISSUE8(wa, Ub2, f0, f1)
                AWAIT8(10, wb);
#pragma unroll
                for (int m = 0; m < 8; ++m) pd[8 + m] = dot32_i4(wb[m], cA, cB);
                asm volatile("" : "+v"(pd[8]), "+v"(pd[9]), "+v"(pd[10]), "+v"(pd[11]), "+v"(pd[12]), "+v"(pd[13]), "+v"(pd[14]), "+v"(pd[15]) :: "memory");
                ISSUE8(wb, Ub2, f2, f3)
#pragma unroll
                for (int m = 0; m < 8; ++m) { const bool up = (c & 4) != 0; const int keep = up ? pd[m + 8] : pd[m], give = up ? pd[m] : pd[m + 8]; pd[m] = keep + sxori<4>(give); }
#pragma unroll
                for (int m = 0; m < 4; ++m) { const bool up = (c & 2) != 0; const int keep = up ? pd[m + 4] : pd[m], give = up ? pd[m] : pd[m + 4]; pd[m] = keep + sxori<2>(give); }
#pragma unroll
                for (int m = 0; m < 2; ++m) { const bool up = (c & 1) != 0; const int keep = up ? pd[m + 2] : pd[m], give = up ? pd[m] : pd[m + 2]; pd[m] = keep + sxori<1>(give); }
                LAS i32x2_t* ap = (LAS i32x2_t*)(cf + i * 128 + j * 16 + 2 * c);
                i32x2_t a = (i32x2_t){pd[0], pd[1]};
                if (cb > 0) a += *ap;
                if (cb == 3 && t < T) {
                    const int k0 = 16 * c + j;
                    const f32x2_t hq = *(const f32x2_t*)(HQS + 2 * (size_t)t);
                    const float ox = GATE[(size_t)t * 128 + k0] * gelu_exact(((float)a.x + hq.y) * hq.x), oy = GATE[(size_t)t * 128 + k0 + 8] * gelu_exact(((float)a.y + hq.y) * hq.x);
                    const float cmax = fmaxf(wave_max(fmaxf(fabsf(ox), fabsf(oy))), 1.0e-30f), qs = 127.0f / cmax;
                    const int cx = (int)__builtin_rintf(ox * qs), cy = (int)__builtin_rintf(oy * qs);
                    const float csum = wave_sum((float)(cx + cy));
                    LAS unsigned char* tokb = (LAS unsigned char*)(cf + i * 128);
                    *(LAS unsigned short*)(tokb + j * 16 + 2 * c) = (unsigned short)((cx & 255) | ((cy & 255) << 8));
                    if (lane == 0) *(LAS f32x2_t*)(tokb + 128) = (f32x2_t){cmax * (V_STEP / 127.0f), csum};
                } else *ap = a;
            }
            asm volatile("s_waitcnt vmcnt(0)" : "+v"(hA), "+v"(hB), "+v"(wa[0]), "+v"(wa[1]), "+v"(wa[2]), "+v"(wa[3]), "+v"(wa[4]), "+v"(wa[5]), "+v"(wa[6]), "+v"(wa[7]) :: "memory");
            AWAIT8(0, wb);
        }
        {
            u32x4 wa[8], wb[8];
            {   const LAS u32x4* ie = (const LAS u32x4*)(ix + j * 16); const u32x4 e0 = ie[0], e1 = ie[1], e2 = ie[2], e3 = ie[3]; const unsigned char* Vb0 = VB;
                ISSUE8(wa, Vb0, e0, e1) ISSUE8(wb, Vb0, e2, e3) }
#pragma unroll 1
            for (int r = 0; r < 64; ++r) {
                const int cb = r >> 4, i = r & 15, t = tb + i;
                const int r2 = r < 63 ? r + 1 : 63, cb2 = r2 >> 4, i2 = r2 & 15;
                const unsigned char* Vb2 = VB + (size_t)cb2 * NEXP * 128;
                const LAS u32x4* ie2 = (const LAS u32x4*)(ix + i2 * 128 + j * 16); const u32x4 f0 = ie2[0], f1 = ie2[1], f2 = ie2[2], f3 = ie2[3];
                const LAS unsigned char* tokb = (const LAS unsigned char*)(cf + i * 128);
                const u32x4 c8 = *(const LAS u32x4*)(tokb + j * 16); const f32x2_t sq = *(const LAS f32x2_t*)(tokb + 128);
                AWAIT8(8, wa);
                int Lo[16], By[16];
#pragma unroll
                for (int q = 0; q < 16; ++q) { Lo[q] = 0; By[q] = 0; }
                vdot_group(Lo, By, wa[0], wa[1], wa[2], wa[3], c8.x); __builtin_amdgcn_sched_barrier(0);
                vdot_group(Lo, By, wa[4], wa[5], wa[6], wa[7], c8.y); __builtin_amdgcn_sched_barrier(0);
                asm volatile("" : "+v"(Lo[0]), "+v"(Lo[4]), "+v"(Lo[8]), "+v"(Lo[12]), "+v"(By[0]), "+v"(By[4]), "+v"(By[8]), "+v"(By[12]), "+v"(By[15]) :: "memory");
                ISSUE8(wa, Vb2, f0, f1)
                AWAIT8(8, wb);
                vdot_group(Lo, By, wb[0], wb[1], wb[2], wb[3], c8.z); __builtin_amdgcn_sched_barrier(0);
                vdot_group(Lo, By, wb[4], wb[5], wb[6], wb[7], c8.w); __builtin_amdgcn_sched_barrier(0);
                asm volatile("" : "+v"(Lo[0]), "+v"(Lo[4]), "+v"(Lo[8]), "+v"(Lo[12]), "+v"(By[0]), "+v"(By[4]), "+v"(By[8]), "+v"(By[12]), "+v"(By[15]) :: "memory");
                ISSUE8(wb, Vb2, f2, f3)
                int acc[32];
#pragma unroll
                for (int q = 0; q < 16; ++q) { acc[2 * q] = Lo[q]; acc[2 * q + 1] = By[q]; }
#pragma unroll
                for (int m = 0; m < 16; ++m) { int a = acc[m], b = acc[m + 16]; swap32i(a, b); acc[m] = a + b; }
#pragma unroll
                for (int m = 0; m < 8; ++m) { int a = acc[m], b = acc[m + 8]; swap16i(a, b); acc[m] = a + b; }
#pragma unroll
                for (int m = 0; m < 4; ++m) { const bool up = (j & 1) != 0; const int keep = up ? acc[m + 4] : acc[m], give = up ? acc[m] : acc[m + 4]; acc[m] = keep + sxori<8>(give); }
                const float o0 = sq.x * ((float)acc[0] - 7.5f * sq.y), o1 = sq.x * ((float)((acc[1] - acc[0]) >> 4) + 0.5f * sq.y);
                const float o2 = sq.x * ((float)acc[2] - 7.5f * sq.y), o3 = sq.x * ((float)((acc[3] - acc[2]) >> 4) + 0.5f * sq.y);
                if (t < T) *(u32x2*)(OUTF + (size_t)t * D + 256 * cb + 32 * c + 4 * j) = (u32x2){pk2(o0, o1), pk2(o2, o3)};
            }
            AWAIT8(0, wa); AWAIT8(0, wb);
        }
#undef ALOAD
#undef ALOADO
#undef ALOADT
#undef ALOADOT
#undef AWAIT8
#undef ISSUE8
        int ln = lane; asm volatile("" : "+v"(ln));
        if (tb < T) {
            const int bidx = tb / SEQ;
            const float* m = mod + ((size_t)l * 16 + bidx) * 6144;
            float g2[16], gg[16], bb[16], sh[16], sc[16];
            rowc_load_f32(m + 5120, ln, g2); rowc_load_f32(p->ln2_g + l * D, ln, gg); rowc_load_f32(p->ln2_b + l * D, ln, bb);
            if (!last) { const float* mn = mod + ((size_t)(l + 1) * 16 + bidx) * 6144; rowc_load_f32(mn, ln, sh); rowc_load_f32(mn + 1024, ln, sc); }
            u32x4 nx0 = *(const u32x4*)(X1 + (size_t)tb * D + 16 * ln), nx1 = *(const u32x4*)(X1 + (size_t)tb * D + 16 * ln + 8);
            u32x4 no0 = *(const u32x4*)(OUTF + (size_t)tb * D + 16 * ln), no1 = *(const u32x4*)(OUTF + (size_t)tb * D + 16 * ln + 8);
#pragma unroll 1
            for (int i = 0; i < 16; ++i) { const int t = tb + i; if (t >= T) break;
                const u32x4 x0 = nx0, x1 = nx1, o0 = no0, o1 = no1;
                if (i + 1 < 16 && t + 1 < T) { const size_t tn = (size_t)(t + 1) * D + 16 * ln;
                    nx0 = *(const u32x4*)(X1 + tn); nx1 = *(const u32x4*)(X1 + tn + 8); no0 = *(const u32x4*)(OUTF + tn); no1 = *(const u32x4*)(OUTF + tn + 8); }
                float xv[16];
                { const unsigned xw[8] = {x0.x, x0.y, x0.z, x0.w, x1.x, x1.y, x1.z, x1.w}, ow[8] = {o0.x, o0.y, o0.z, o0.w, o1.x, o1.y, o1.z, o1.w};
#pragma unroll
                  for (int q = 0; q < 8; ++q) { xv[2 * q] = ALPHA * bf_lo(xw[q]) + (1.0f + g2[2 * q]) * bf_lo(ow[q]); xv[2 * q + 1] = ALPHA * bf_hi(xw[q]) + (1.0f + g2[2 * q + 1]) * bf_hi(ow[q]); } }
                row_normalize(xv);
#pragma unroll
                for (int q = 0; q < 16; ++q) xv[q] = xv[q] * gg[q] + bb[q];
                if (last) rowc_store_f32(XO + (size_t)t * D, ln, xv);
                if (!last) {
                    rowc_store_bf16(X2B + (size_t)t * D, ln, xv);
                    row_normalize(xv);
#pragma unroll
                    for (int q = 0; q < 16; ++q) xv[q] = xv[q] * (1.0f + sc[q]) + sh[q];
                    rowc_store_bf16(H1 + (size_t)t * D, ln, xv);
                }
            }
        }
    }
}

#define XB_TMO      128
#define XB_XCNT(j)  (256  + 64 * (j))
#define XB_XSUB(j)  (1280 + 64 * (j))
#define XB_XGEN(j)  (2304 + 64 * (j))
#define XB_TOP      3328
#define XB_TOPGEN   3392
#define XCD_BAR_WORDS 3456
#define XB_SPIN_CAP (1u << 18)

__device__ __forceinline__ unsigned xb_ld(unsigned* p)              { return __hip_atomic_load(p, __ATOMIC_RELAXED, __HIP_MEMORY_SCOPE_AGENT); }
__device__ __forceinline__ unsigned xb_add(unsigned* p, unsigned v) { return __hip_atomic_fetch_add(p, v, __ATOMIC_RELAXED, __HIP_MEMORY_SCOPE_AGENT); }
__device__ __forceinline__ unsigned xb_xcc_id() { return (unsigned)__builtin_amdgcn_s_getreg((3 << 11) | 20) & 0xFu; }
#define XB_SPIN(cond, bar) do { unsigned _sp = 0; while (cond) { __builtin_amdgcn_s_sleep(1); \
    if ((++_sp & 255u) == 0u) { if (xb_ld(&(bar)[XB_TMO])) break; if (_sp > XB_SPIN_CAP) { atomicAdd(&(bar)[XB_TMO], 1u); break; } } } } while (0)

struct XcdBarrier {
    unsigned* bar; unsigned x;
    volatile LAS unsigned* st;
};

__device__ __forceinline__ XcdBarrier xcd_barrier_post(unsigned* bar, volatile LAS unsigned* st, bool leader) {
    XcdBarrier b; b.bar = bar; b.x = xb_xcc_id(); b.st = st;
    if (leader) (void)xb_add(&bar[XB_XCNT(b.x)], 1u);
    return b;
}
__device__ __forceinline__ void xcd_barrier_complete(unsigned* bar, unsigned x, unsigned& nloc, unsigned& nx) {
    const unsigned G = gridDim.x * gridDim.y * gridDim.z;
    unsigned sum, cnt, mine, sp = 0u;
    for (;;) {
        sum = 0u; cnt = 0u; mine = 0u;
#pragma unroll
        for (unsigned j = 0; j < 16; ++j) { const unsigned c = xb_ld(&bar[XB_XCNT(j)]); sum += c; cnt += (c > 0u) ? 1u : 0u; mine = (j == x) ? c : mine; }
        if (sum == G) break;
        __builtin_amdgcn_s_sleep(1);
        if ((++sp & 255u) == 0u) { if (xb_ld(&bar[XB_TMO])) break; if (sp > XB_SPIN_CAP) { atomicAdd(&bar[XB_TMO], 1u); break; } }
    }
    nloc = mine > 0u ? mine : 1u; nx = cnt > 0u ? cnt : 1u;
}

__device__ __forceinline__ void xcd_barrier(const XcdBarrier& b, bool leader) {
    asm volatile("s_waitcnt vmcnt(0)" ::: "memory");
    __syncthreads();
    if (leader) {
        unsigned* bar = b.bar; asm volatile("" : "+s"(bar));
        __builtin_amdgcn_s_waitcnt(0);
        unsigned nloc = b.st[0], nx = b.st[1];
        if (nloc == 0u) { xcd_barrier_complete(bar, b.x, nloc, nx); b.st[0] = nloc; b.st[1] = nx; }
        const unsigned old = xb_add(&bar[XB_XSUB(b.x)], 1u);
        const unsigned gen = old / nloc;
        if (old + 1u == (gen + 1u) * nloc) {
            __builtin_amdgcn_fence(__ATOMIC_RELEASE, "agent");
            asm volatile("s_waitcnt vmcnt(0)" ::: "memory");
            const unsigned og = xb_add(&bar[XB_TOP], 1u);
            const unsigned tg = og / nx;
            if (og + 1u == (tg + 1u) * nx) xb_add(&bar[XB_TOPGEN], 1u);
            else XB_SPIN(xb_ld(&bar[XB_TOPGEN]) == tg, bar);
            __builtin_amdgcn_fence(__ATOMIC_ACQUIRE, "agent");
            xb_add(&bar[XB_XGEN(b.x)], 1u);
            asm volatile("s_waitcnt vmcnt(0)" ::: "memory");
        } else {
            XB_SPIN(xb_ld(&bar[XB_XGEN(b.x)]) == gen, bar);
            __builtin_amdgcn_fence(__ATOMIC_ACQUIRE, "agent");
            asm volatile("s_waitcnt vmcnt(0)" ::: "memory");
        }
    }
    __syncthreads();
}
namespace cg = cooperative_groups;
extern __shared__ __attribute__((aligned(16))) unsigned char dyn_lds[];
__global__ void __launch_bounds__(NTHR, 2) mega(Params kernel_args) {
    (void)kernel_args;
    KParams p = (KParams)__builtin_amdgcn_kernarg_segment_ptr();
    cg::grid_group grid = cg::this_grid();
    LAS unsigned char* lds = (LAS unsigned char*)dyn_lds;
    int bid = blockIdx.x, nb = gridDim.x; const int wid_s = __builtin_amdgcn_readfirstlane(threadIdx.x >> 6);
    unsigned char* ws = p->ws;
    volatile LAS unsigned* bar_st = (volatile LAS unsigned*)(lds + LDS_BYTES - 64);
    const bool leader = (opaque_tid(wid_s) == 0);
    if (leader) { bar_st[0] = 0u; bar_st[1] = 0u; }
    __syncthreads();
    (void)xcd_barrier_post((unsigned*)(ws + WS_CTL + 16384), bar_st, leader);
#define GRID_BAR() { XcdBarrier xb_; xb_.bar = (unsigned*)(ws + WS_CTL + 16384); xb_.x = xb_xcc_id(); xb_.st = (volatile LAS unsigned*)(lds + LDS_BYTES - 64); xcd_barrier(xb_, opaque_tid(wid_s) == 0); }
#define OPQ_SEEDS() asm volatile("" : "+s"(ws), "+s"(p), "+s"(bid), "+s"(nb))
    OPQ_SEEDS();
    phase_prep_weights(p, lds, bid, nb, wid_s);
    __syncthreads();
    phase_mod(p, lds, bid, nb, wid_s);
    phase_prep_tables(p, bid, nb, wid_s);
    grid.sync();
    OPQ_SEEDS();
    phase_rowA(p, 0, p->x, bid, nb, wid_s);
    GRID_BAR();
#pragma unroll
    for (int l = 0; l < NL; ++l) {
        OPQ_SEEDS();
        {
            EpiProj e{p};
            gemm_fast(lds, (const bf16_t*)(ws + WS_H1), (const bf16_t*)(ws + WS_WIN) + (size_t)l * NPROJ * D, T, NPROJ, D, e, bid, nb, wid_s);
        }
        GRID_BAR(); OPQ_SEEDS();
        {
            EpiQ eq{p};
            gemm_fast(lds, (const bf16_t*)(ws + WS_QLAT), (const bf16_t*)(ws + WS_WUQ) + (size_t)l * 768 * 256, T, 768, 256, eq, bid, nb, wid_s);
            EpiKV ek{p};
            gemm_fast(lds, (const bf16_t*)(ws + WS_KVLAT), (const bf16_t*)(ws + WS_WUKV) + (size_t)l * 1024 * 128, T, 1024, 128, ek, bid, nb, wid_s);
            phase_conv_krope(p, l, bid, nb, wid_s);
        }
        GRID_BAR(); OPQ_SEEDS();
        phase_mla(p, lds, bid, nb, wid_s);
        phase_sb(p, lds, bid, nb, wid_s);
        GRID_BAR(); OPQ_SEEDS();
        {
            EpiY e{p, l};
            gemm_fast(lds, (const bf16_t*)(ws + WS_CONCAT), (const bf16_t*)(ws + WS_WO) + (size_t)l * D * D, T, D, D, e, bid, nb, wid_s);
        }
        GRID_BAR(); OPQ_SEEDS();
        phase_rowF(p, l, bid, nb, wid_s);
        GRID_BAR(); OPQ_SEEDS();
        {
            EpiBf e{p};
            gemm_fast(lds, (const bf16_t*)(ws + WS_H2), (const bf16_t*)(ws + WS_WQ) + (size_t)l * 2048 * D, T, 2048, D, e, bid, nb, wid_s);
        }
        GRID_BAR(); OPQ_SEEDS();
        phase_topk(p, l, lds, bid, nb, wid_s);
        GRID_BAR(); OPQ_SEEDS();
        phase_experts(p, l, l == NL - 1, lds, bid, nb, wid_s);
        if (l + 1 < NL) GRID_BAR();
    }
}

extern "C" void kernel_launch(void* const* d_in, const int* in_sizes, int n_in, void* d_out, int out_size, void* d_ws, size_t ws_size, hipStream_t stream) {
    static int grid_blocks = 0;
    if (grid_blocks == 0) {
        grid_blocks = -1;
        if (n_in != 21 || out_size != T * D || ws_size < WS_END) { fprintf(stderr, "kernel_launch: unexpected shapes (n_in %d, out %d, ws %zu)\n", n_in, out_size, ws_size); return; }
        if (hipFuncSetAttribute((const void*)mega, hipFuncAttributeMaxDynamicSharedMemorySize, LDS_BYTES) != hipSuccess) { fprintf(stderr, "kernel_launch: hipFuncSetAttribute failed\n"); return; }
        int dev = 0, cus = 0, per_cu = 0;
        if (hipGetDevice(&dev) != hipSuccess || hipDeviceGetAttribute(&cus, hipDeviceAttributeMultiprocessorCount, dev) != hipSuccess) { fprintf(stderr, "kernel_launch: device query failed\n"); return; }
        if (hipOccupancyMaxActiveBlocksPerMultiprocessor(&per_cu, (const void*)mega, NTHR, LDS_BYTES) != hipSuccess || per_cu < 1) { fprintf(stderr, "kernel_launch: occupancy query failed (%d)\n", per_cu); return; }
        grid_blocks = cus * 1;
    }
    if (grid_blocks < 0) return;
    Params hp{};
    hp.x = (const float*)d_in[0]; hp.c = (const float*)d_in[1]; hp.pos = (const int*)d_in[2]; hp.ada_w = (const float*)d_in[3]; hp.ada_b = (const float*)d_in[4];
    hp.w_in = (const float*)d_in[5]; hp.qg = (const float*)d_in[6]; hp.kvg = (const float*)d_in[7]; hp.w_uq = (const float*)d_in[8]; hp.w_ukv = (const float*)d_in[9];
    hp.conv_w = (const float*)d_in[10]; hp.w_o = (const float*)d_in[11]; hp.ln1_g = (const float*)d_in[12]; hp.ln1_b = (const float*)d_in[13]; hp.wq = (const float*)d_in[14];
    hp.k1 = (const float*)d_in[15]; hp.k2 = (const float*)d_in[16]; hp.pu = (const float*)d_in[17]; hp.pv = (const float*)d_in[18]; hp.ln2_g = (const float*)d_in[19]; hp.ln2_b = (const float*)d_in[20];
    hp.out = (float*)d_out; hp.ws = (unsigned char*)d_ws;
    (void)hipMemsetAsync((char*)d_ws + WS_CTL, 0, CTL_BYTES, stream);
    void* args[] = {&hp};
    hipError_t e = hipLaunchCooperativeKernel((const void*)mega, dim3(grid_blocks), dim3(NTHR), args, LDS_BYTES, stream);
    if (e != hipSuccess) fprintf(stderr, "kernel_launch: cooperative launch failed: %s (grid %d)\n", hipGetErrorString(e), grid_blocks);
}
```

```cpp
#include <hip/hip_runtime.h>
#include <hip/hip_cooperative_groups.h>
#include <cstdio>
#include <cstdint>

#define LAS __attribute__((address_space(3)))
typedef unsigned short bf16_t;
typedef short bf16x8 __attribute__((ext_vector_type(8)));
typedef float f32x4 __attribute__((ext_vector_type(4)));
typedef float f32x16 __attribute__((ext_vector_type(16)));
typedef unsigned u32x4 __attribute__((ext_vector_type(4)));
typedef unsigned u32x2 __attribute__((ext_vector_type(2)));

constexpr int D = 1024, NB = 16, SEQ = 2048, T = NB * SEQ, NL = 2;
constexpr int NPROJ = 2048;
constexpr int NEXP = 16384;
constexpr float LN_EPS = 1e-5f, RMS_EPS = 1e-6f;
constexpr float ALPHA = 1.4142135623730951f;
constexpr float LOG2E = 1.4426950408889634f;
constexpr float CQ = 0.10206207261596577f * LOG2E;
constexpr float SBQ_SCALE = 0.125f * LOG2E;
constexpr int PC_QLAT = 0, PC_KVLAT = 256, PC_CB = 384, PC_CC = 640, PC_CH = 896, PC_SBQ = 1152, PC_SBK = 1408, PC_SBV = 1664, PC_KROPE = 1920, PC_END = 1952;

constexpr size_t MiB = 1u << 20;
constexpr size_t WS_CTL = 0, CTL_BYTES = 1 * MiB;
constexpr size_t WS_SSQQ = 6 * MiB, WS_SSQKV = 7 * MiB;
constexpr size_t WS_MOD = 1 * MiB;
constexpr size_t WS_COS = 2 * MiB, WS_SIN = 4 * MiB;
constexpr size_t WS_WIN = 8 * MiB;
constexpr size_t WS_WO = 16 * MiB;
constexpr size_t WS_WQ = 20 * MiB;
constexpr size_t WS_WUQ = 28 * MiB;
constexpr size_t WS_WUKV = 29 * MiB;
constexpr size_t WS_K1 = 30 * MiB, WS_K2 = 30 * MiB + 512 * 1024;
constexpr size_t WS_IDX = 32 * MiB, WS_QLAT = 32 * MiB;
constexpr size_t WS_GATE = 48 * MiB, WS_KVLAT = 48 * MiB;
constexpr size_t WS_H1 = 64 * MiB, WS_CONCAT = 64 * MiB;
constexpr size_t WS_H2 = 128 * MiB;
constexpr size_t WS_SBX = 128 * MiB;
constexpr int SBX_PITCH = 832;
constexpr size_t WS_PROJ = 192 * MiB, WS_PQ = 192 * MiB;
constexpr size_t WS_X2 = 320 * MiB;
constexpr size_t WS_H2Q = 384 * MiB;
constexpr size_t WS_HQS = 7 * MiB + 512 * 1024;
constexpr size_t WS_UB = 448 * MiB, WS_VB = 480 * MiB;
constexpr size_t WS_END = 512 * MiB;
constexpr size_t OUT_Q = 0, OUT_K = 48 * MiB, OUT_V = 96 * MiB;

constexpr int LDS_BYTES = 147456;
constexpr int NTHR = 512;

struct Params {
    const float *x, *c; const int* pos;
    const float *ada_w, *ada_b, *w_in, *qg, *kvg, *w_uq, *w_ukv, *conv_w, *w_o, *ln1_g, *ln1_b, *wq, *k1, *k2, *pu, *pv, *ln2_g, *ln2_b;
    float* out; unsigned char* ws;
};

typedef const __attribute__((address_space(4))) Params* KParams;
__device__ __forceinline__ unsigned pk2(float lo, float hi) { unsigned r; asm("v_cvt_pk_bf16_f32 %0, %1, %2" : "=v"(r) : "v"(lo), "v"(hi)); return r; }
__device__ __forceinline__ unsigned f2bf(float f) { return pk2(f, f) & 0xffffu; }
__device__ __forceinline__ float bf_lo(unsigned u) { return __builtin_bit_cast(float, u << 16); }
__device__ __forceinline__ float bf_hi(unsigned u) { return __builtin_bit_cast(float, u & 0xffff0000u); }
__device__ __forceinline__ float bf2f(bf16_t h) { return __builtin_bit_cast(float, (unsigned)h << 16); }
template <int M> __device__ __forceinline__ float sxor(float v) {
    static_assert(M == 1 || M == 2 || M == 4 || M == 8 || M == 16, "sxor mask");
    return __builtin_bit_cast(float, __builtin_amdgcn_ds_swizzle(__builtin_bit_cast(int, v), 0x1F | (M << 10)));
}
__device__ __forceinline__ void swap32(float& a, float& b) {
    const auto r = __builtin_amdgcn_permlane32_swap(__builtin_bit_cast(unsigned, a), __builtin_bit_cast(unsigned, b), false, false);
    a = __builtin_bit_cast(float, (unsigned)r[0]); b = __builtin_bit_cast(float, (unsigned)r[1]);
}
__device__ __forceinline__ void swap16(float& a, float& b) {
    const auto r = __builtin_amdgcn_permlane16_swap(__builtin_bit_cast(unsigned, a), __builtin_bit_cast(unsigned, b), false, false);
    a = __builtin_bit_cast(float, (unsigned)r[0]); b = __builtin_bit_cast(float, (unsigned)r[1]);
}
__device__ __forceinline__ float sum_x32(float v) { float a = v, b = v; swap32(a, b); return a + b; }
__device__ __forceinline__ float max_x32(float v) { float a = v, b = v; swap32(a, b); return fmaxf(a, b); }
__device__ __forceinline__ float wave_sum(float v) {
    v += sxor<1>(v); v += sxor<2>(v); v += sxor<4>(v); v += sxor<8>(v); v += sxor<16>(v);
    return sum_x32(v);
}
__device__ __forceinline__ float wave_max(float v) {
    v = fmaxf(v, sxor<1>(v)); v = fmaxf(v, sxor<2>(v)); v = fmaxf(v, sxor<4>(v)); v = fmaxf(v, sxor<8>(v)); v = fmaxf(v, sxor<16>(v));
    return max_x32(v);
}
template <int M> __device__ __forceinline__ int sxori(int v) { return __builtin_amdgcn_ds_swizzle(v, 0x1F | (M << 10)); }
typedef float f32x2_t __attribute__((ext_vector_type(2)));
typedef int i32x2_t __attribute__((ext_vector_type(2)));
__device__ __forceinline__ float vmaxf(float a, float b) { return __builtin_amdgcn_fmed3f(a, b, __builtin_inff()); }
__device__ __forceinline__ float vminf(float a, float b) { return __builtin_amdgcn_fmed3f(a, b, -__builtin_inff()); }
__device__ __forceinline__ float vmin0f(float a) { float r; asm("v_min_f32 %0, 0, %1" : "=v"(r) : "v"(a)); return r; }

__device__ __forceinline__ int opaque_tid(int wid_s) { int lane; asm volatile("v_mbcnt_lo_u32_b32 %0, -1, 0\n\tv_mbcnt_hi_u32_b32 %0, -1, %0" : "=v"(lane)); return (wid_s << 6) | lane; }

#define OPQF(name, val) float name = (val); asm volatile("" : "+v"(name))
__device__ __forceinline__ float gelu_exact(float x) {
    OPQF(P, 0.3275911f); OPQF(A1, 0.254829592f); OPQF(A2, -0.284496736f); OPQF(A3, 1.421413741f); OPQF(A4, -1.453152027f); OPQF(A5, 1.061405429f); OPQF(RS2, 0.70710678118654752f);
    const float z = fabsf(x) * RS2, t = __builtin_amdgcn_rcpf(1.0f + P * z);
    const float poly = ((((A5 * t + A4) * t + A3) * t + A2) * t + A1) * t;
    const float erfa = 1.0f - poly * __expf(-z * z);
    const float erfx = x < 0.f ? -erfa : erfa;
    return 0.5f * x * (1.0f + erfx);
}
__device__ __forceinline__ void sincos_f32(float ang, float& sn, float& cs) {
    double TWO_OVER_PI = 0.63661977236758134; asm volatile("" : "+v"(TWO_OVER_PI));
    double PI_OVER_2 = 1.5707963267948966; asm volatile("" : "+v"(PI_OVER_2));
    const double a = (double)ang, nq = __builtin_rint(a * TWO_OVER_PI);
    const float r = (float)__builtin_fma(-nq, PI_OVER_2, a), r2 = r * r;
    const int q = (int)nq & 3;
    OPQF(S3, -1.6666667e-1f); OPQF(S5, 8.3333333e-3f); OPQF(S7, -1.9841270e-4f); OPQF(S9, 2.7557319e-6f);
    OPQF(C2, -0.5f); OPQF(C4, 4.1666667e-2f); OPQF(C6, -1.3888889e-3f); OPQF(C8, 2.4801587e-5f); OPQF(C10, -2.7557319e-7f);
    const float s = r + r * r2 * (S3 + r2 * (S5 + r2 * (S7 + r2 * S9)));
    const float c = 1.0f + r2 * (C2 + r2 * (C4 + r2 * (C6 + r2 * (C8 + r2 * C10))));
    sn = (q == 0) ? s : (q == 1) ? c : (q == 2) ? -s : -c;
    cs = (q == 0) ? c : (q == 1) ? -s : (q == 2) ? -c : s;
}
__device__ const float ROPE_INV_FREQ[16] = {1.0f, 0.5623413251903491f, 0.31622776601683794f, 0.1778279410038923f, 0.1f, 0.05623413251903491f, 0.03162277660168379f, 0.01778279410038923f,
                                            0.01f, 0.005623413251903491f, 0.0031622776601683794f, 0.0017782794100389228f, 0.001f, 0.0005623413251903491f, 0.00031622776601683794f, 0.00017782794100389227f};
__device__ __forceinline__ void transpose_item(const float* W, int ldw, int K, bf16_t* WT, int n_src0, int n_dst0, int k0, const float* kscale, bool zero, LAS float* scr, int lane) {
    if (!zero) {
        f32x4 w[8];
        const float* src = W + (size_t)(k0 + (lane >> 3)) * ldw + n_src0 + 4 * (lane & 7);
#pragma unroll
        for (int u = 0; u < 8; ++u) w[u] = *(const f32x4*)(src + (size_t)(8 * u) * ldw);
#pragma unroll
        for (int u = 0; u < 8; ++u) { const int kk = 8 * u + (lane >> 3); f32x4 v = w[u]; if (kscale) { const float sc = kscale[k0 + kk]; v.x *= sc; v.y *= sc; v.z *= sc; v.w *= sc; }
            LAS float* d = scr + kk * 33 + 4 * (lane & 7); d[0] = v.x; d[1] = v.y; d[2] = v.z; d[3] = v.w; }
    }
    asm volatile("s_waitcnt lgkmcnt(0)" ::: "memory");
    const int c = lane & 7;
#pragma unroll
    for (int j = 0; j < 4; ++j) {
        const int n = (lane >> 3) + 8 * j; const LAS float* s = scr + (8 * c) * 33 + n;
        u32x4 o;
        if (zero) { unsigned z = 0u; asm volatile("" : "+v"(z)); o = (u32x4){z, z, z, z}; }
        else { o.x = pk2(s[0 * 33], s[1 * 33]); o.y = pk2(s[2 * 33], s[3 * 33]); o.z = pk2(s[4 * 33], s[5 * 33]); o.w = pk2(s[6 * 33], s[7 * 33]); }
        *(u32x4*)(WT + (size_t)(n_dst0 + n) * K + k0 + 8 * c) = o;
    }
    asm volatile("s_waitcnt lgkmcnt(0)" ::: "memory");
}

__device__ __forceinline__ int proj_src_col(int n) {
    if (n < 384) return n;
    if (n < 1920) return n + 32;
    if (n < 1952) return n - 1920 + 384;
    return -1;
}

__device__ __forceinline__ void phase_prep_weights(KParams p, LAS unsigned char* lds, int bid, int nb, int wid_s) {
    const int tidx = opaque_tid(wid_s);
    const int tid = tidx, lane = tid & 63, wave = tid >> 6;
    LAS float* scr = (LAS float*)(lds + wave * 16384);
    const int gw = bid * 8 + wave, ngw = nb * 8;
    constexpr int I_WIN = 16 * 64, I_WO = 16 * 32, I_WQ = 16 * 64, I_UQ = 4 * 24, I_UKV = 2 * 32;
    constexpr int I_L = I_WIN + I_WO + I_WQ + I_UQ + I_UKV;
    for (int it = gw; it < NL * I_L; it += ngw) {
        const int l = it / I_L; int r = it % I_L;
        if (r < I_WIN) { const int kb = r / 64, nbk = r % 64, n0 = nbk * 32, src = proj_src_col(n0);
            transpose_item(p->w_in + (size_t)l * D * PC_END, PC_END, D, (bf16_t*)(p->ws + WS_WIN) + (size_t)l * NPROJ * D, src < 0 ? 0 : src, n0, kb * 64, nullptr, src < 0, scr, lane); continue; }
        r -= I_WIN;
        if (r < I_WO) { const int kb = r / 32, nbk = r % 32;
            transpose_item(p->w_o + (size_t)l * D * D, D, D, (bf16_t*)(p->ws + WS_WO) + (size_t)l * D * D, nbk * 32, nbk * 32, kb * 64, nullptr, false, scr, lane); continue; }
        r -= I_WO;
        if (r < I_WQ) { const int kb = r / 64, nbk = r % 64;
            transpose_item(p->wq + (size_t)l * D * 2048, 2048, D, (bf16_t*)(p->ws + WS_WQ) + (size_t)l * 2048 * D, nbk * 32, nbk * 32, kb * 64, nullptr, false, scr, lane); continue; }
        r -= I_WQ;
        if (r < I_UQ) { const int kb = r / 24, nbk = r % 24;
            transpose_item(p->w_uq + (size_t)l * 256 * 768, 768, 256, (bf16_t*)(p->ws + WS_WUQ) + (size_t)l * 768 * 256, nbk * 32, nbk * 32, kb * 64, p->qg + l * 256, false, scr, lane); continue; }
        r -= I_UQ;
        { const int kb = r / 32, nbk = r % 32;
            transpose_item(p->w_ukv + (size_t)l * 128 * 1024, 1024, 128, (bf16_t*)(p->ws + WS_WUKV) + (size_t)l * 1024 * 128, nbk * 32, nbk * 32, kb * 64, p->kvg + l * 128, false, scr, lane); }
    }
    const int gt = bid * NTHR + tid, ngt = nb * NTHR;
    bf16_t* k1b = (bf16_t*)(p->ws + WS_K1); bf16_t* k2b = (bf16_t*)(p->ws + WS_K2);
    for (int i = gt; i < NL * 8 * 128 * 128; i += ngt) { k1b[i] = (bf16_t)f2bf(p->k1[i]); k2b[i] = (bf16_t)f2bf(p->k2[i]); }
    float* cosT = (float*)(p->ws + WS_COS); float* sinT = (float*)(p->ws + WS_SIN);
    for (int i = gt; i < T * 16; i += ngt) {
        const int t = i >> 4, j = i & 15;
        const float ang = (float)p->pos[t] * ROPE_INV_FREQ[j];
        float sn, cs; sincos_f32(ang, sn, cs);
        cosT[i] = cs; sinT[i] = sn;
    }
}

constexpr size_t TAB4_LAYER = (size_t)NEXP * 512;
constexpr float U_STEP = 0.3352f / 32.0f, V_STEP = 0.3352f * 0.17677669529663687f;
__device__ __forceinline__ unsigned enc_i4b(float x, float sc) { return (unsigned)__builtin_amdgcn_fmed3f(__builtin_fmaf(x, sc, 8.0f), 0.0f, 15.5f); }
__device__ __forceinline__ u32x4 pack32_i4(const f32x4* src, float sc, unsigned flip) {
    unsigned w[4];
#pragma unroll
    for (int d = 0; d < 4; ++d) {
        const f32x4 a = src[2 * d], b = src[2 * d + 1];
        w[d] = (enc_i4b(a.x, sc) | (enc_i4b(a.y, sc) << 4) | (enc_i4b(a.z, sc) << 8) | (enc_i4b(a.w, sc) << 12) | (enc_i4b(b.x, sc) << 16) | (enc_i4b(b.y, sc) << 20) | (enc_i4b(b.z, sc) << 24) | (enc_i4b(b.w, sc) << 28)) ^ flip;
    }
    return (u32x4){w[0], w[1], w[2], w[3]};
}
__device__ __forceinline__ void phase_prep_tables(KParams p, int bid, int nb, int wid_s) {
    const int tidx = opaque_tid(wid_s);
    const int gt = bid * NTHR + tidx, ngt = nb * NTHR;
    const f32x4* su = (const f32x4*)p->pu; const f32x4* sv = (const f32x4*)p->pv;
    unsigned char* du = p->ws + WS_UB; unsigned char* dv = p->ws + WS_VB;
    for (int i = gt; i < NL * NEXP * D / 32; i += ngt) {
        const int c32 = i & 31, le = i >> 5, e = le & (NEXP - 1), l = le >> 14;
        const size_t dst = ((((size_t)l * 4 + (c32 >> 3)) * NEXP + e) * 128) + (c32 & 7) * 16;
        *(u32x4*)(du + dst) = pack32_i4(su + 8 * (size_t)i, 1.0f / U_STEP, 0x88888888u);
        *(u32x4*)(dv + dst) = pack32_i4(sv + 8 * (size_t)i, 1.0f / V_STEP, 0x80808080u);
    }
}

__device__ __forceinline__ void phase_mod(KParams p, LAS unsigned char* lds, int bid, int nb, int wid_s) {
    const int tidx = opaque_tid(wid_s);
    const int tid = tidx, lane = tid & 63, wave = tid >> 6;
    LAS float* cact = (LAS float*)lds;
    LAS float* part = (LAS float*)(lds + 65536);
    if (bid >= NL * 96) return;
    for (int i = tid; i < NB * D; i += NTHR) { const float v = p->c[i]; cact[(i & 1023) * 16 + (i >> 10)] = v / (1.0f + expf(-v)); }
    __syncthreads();
    float* mod = (float*)(p->ws + WS_MOD);
    for (int item = bid; item < NL * 96; item += nb) {
        const int l = item / 96, col0 = (item % 96) * 64;
        const int kq = lane >> 4, c4 = 4 * (lane & 15);
        const float* W = p->ada_w + (size_t)l * D * 6144 + (size_t)(wave * 128 + kq) * 6144 + col0 + c4;
        f32x4 acc[16];
#pragma unroll
        for (int b = 0; b < 16; ++b) acc[b] = (f32x4){0.f, 0.f, 0.f, 0.f};
#pragma unroll 1
        for (int kb = 0; kb < 128; kb += 32) {
            f32x4 w[8];
#pragma unroll
            for (int u = 0; u < 8; ++u) w[u] = *(const f32x4*)(W + (size_t)(kb + 4 * u) * 6144);
#pragma unroll
            for (int u = 0; u < 8; ++u) {
                const LAS f32x4* cp = (const LAS f32x4*)(cact + (wave * 128 + kb + 4 * u + kq) * 16);
#pragma unroll
                for (int q = 0; q < 4; ++q) { const f32x4 cq = cp[q]; acc[4 * q] += cq.x * w[u]; acc[4 * q + 1] += cq.y * w[u]; acc[4 * q + 2] += cq.z * w[u]; acc[4 * q + 3] += cq.w * w[u]; }
                __builtin_amdgcn_sched_barrier(0);
            }
        }
#pragma unroll
        for (int b = 0; b < 16; ++b) {
            f32x4 a = acc[b];
            a.x += sxor<16>(a.x); a.y += sxor<16>(a.y); a.z += sxor<16>(a.z); a.w += sxor<16>(a.w);
            a.x = sum_x32(a.x); a.y = sum_x32(a.y); a.z = sum_x32(a.z); a.w = sum_x32(a.w);
            if (lane < 16) *(LAS f32x4*)(part + (wave * 16 + b) * 64 + c4) = a;
        }
        __syncthreads();
        for (int o = tid; o < 1024; o += NTHR) {
            const int b = o >> 6, cl = o & 63; float s = p->ada_b[l * 6144 + col0 + cl];
#pragma unroll
            for (int w = 0; w < 8; ++w) s += part[(w * 16 + b) * 64 + cl];
            mod[((size_t)l * 16 + b) * 6144 + col0 + cl] = s;
        }
        __syncthreads();
    }
}

__device__ __forceinline__ void row_load_f32(const float* row, int lane, float (&v)[16]) {
    const f32x4 a = *(const f32x4*)(row + 8 * lane), b = *(const f32x4*)(row + 8 * lane + 4), c = *(const f32x4*)(row + 512 + 8 * lane), d = *(const f32x4*)(row + 512 + 8 * lane + 4);
    v[0] = a.x; v[1] = a.y; v[2] = a.z; v[3] = a.w; v[4] = b.x; v[5] = b.y; v[6] = b.z; v[7] = b.w;
    v[8] = c.x; v[9] = c.y; v[10] = c.z; v[11] = c.w; v[12] = d.x; v[13] = d.y; v[14] = d.z; v[15] = d.w;
}
__device__ __forceinline__ void row_store_f32(float* row, int lane, const float (&v)[16]) {
    *(f32x4*)(row + 8 * lane) = (f32x4){v[0], v[1], v[2], v[3]}; *(f32x4*)(row + 8 * lane + 4) = (f32x4){v[4], v[5], v[6], v[7]};
    *(f32x4*)(row + 512 + 8 * lane) = (f32x4){v[8], v[9], v[10], v[11]}; *(f32x4*)(row + 512 + 8 * lane + 4) = (f32x4){v[12], v[13], v[14], v[15]};
}
__device__ __forceinline__ void row_load_bf16(const bf16_t* row, int lane, float (&v)[16]) {
    const u32x4 a = *(const u32x4*)(row + 8 * lane), b = *(const u32x4*)(row + 512 + 8 * lane);
    v[0] = bf_lo(a.x); v[1] = bf_hi(a.x); v[2] = bf_lo(a.y); v[3] = bf_hi(a.y); v[4] = bf_lo(a.z); v[5] = bf_hi(a.z); v[6] = bf_lo(a.w); v[7] = bf_hi(a.w);
    v[8] = bf_lo(b.x); v[9] = bf_hi(b.x); v[10] = bf_lo(b.y); v[11] = bf_hi(b.y); v[12] = bf_lo(b.z); v[13] = bf_hi(b.z); v[14] = bf_lo(b.w); v[15] = bf_hi(b.w);
}
__device__ __forceinline__ void row_store_bf16(bf16_t* row, int lane, const float (&v)[16]) {
    *(u32x4*)(row + 8 * lane) = (u32x4){pk2(v[0], v[1]), pk2(v[2], v[3]), pk2(v[4], v[5]), pk2(v[6], v[7])};
    *(u32x4*)(row + 512 + 8 * lane) = (u32x4){pk2(v[8], v[9]), pk2(v[10], v[11]), pk2(v[12], v[13]), pk2(v[14], v[15])};
}
__device__ __forceinline__ void row_normalize(float (&v)[16]) {
    float s = 0.f;
#pragma unroll
    for (int i = 0; i < 16; ++i) s += v[i];
    const float mean = wave_sum(s) * (1.0f / D);
    float q = 0.f;
#pragma unroll
    for (int i = 0; i < 16; ++i) { v[i] -= mean; q += v[i] * v[i]; }
    const float rstd = __builtin_amdgcn_rsqf(wave_sum(q) * (1.0f / D) + LN_EPS);
#pragma unroll
    for (int i = 0; i < 16; ++i) v[i] *= rstd;
}
__device__ __forceinline__ void row_modulate(float (&v)[16], const float* shift, const float* scale, int lane) {
    float sh[16], sc[16]; row_load_f32(shift, lane, sh); row_load_f32(scale, lane, sc);
#pragma unroll
    for (int i = 0; i < 16; ++i) v[i] = v[i] * (1.0f + sc[i]) + sh[i];
}
__device__ __forceinline__ void row_affine(float (&v)[16], const float* g, const float* b, int lane) {
    float gg[16], bb[16]; row_load_f32(g, lane, gg); row_load_f32(b, lane, bb);
#pragma unroll
    for (int i = 0; i < 16; ++i) v[i] = v[i] * gg[i] + bb[i];
}

__device__ __forceinline__ void phase_rowA(KParams p, int l, const float* xin, int bid, int nb, int wid_s) {
    const int tidx = opaque_tid(wid_s);
    const int lane = tidx & 63, gw = bid * 8 + (tidx >> 6), ngw = nb * 8;
    const float* mod = (const float*)(p->ws + WS_MOD) + (size_t)l * 16 * 6144;
    bf16_t* H1 = (bf16_t*)(p->ws + WS_H1);
    for (int tb = 16 * gw; tb < T; tb += 16 * ngw) {
        const float* m = mod + (size_t)(tb / SEQ) * 6144;
        float sh[16], sc[16]; row_load_f32(m, lane, sh); row_load_f32(m + 1024, lane, sc);
        float nx[16]; row_load_f32(xin + (size_t)tb * D, lane, nx);
#pragma unroll 1
        for (int i = 0; i < 16; ++i) { const int t = tb + i;
            float v[16];
#pragma unroll
            for (int q = 0; q < 16; ++q) v[q] = nx[q];
            if (i + 1 < 16) row_load_f32(xin + (size_t)(t + 1) * D, lane, nx);
            row_normalize(v);
#pragma unroll
            for (int q = 0; q < 16; ++q) v[q] = v[q] * (1.0f + sc[q]) + sh[q];
            row_store_bf16(H1 + (size_t)t * D, lane, v);
        }
    }
}
__device__ __forceinline__ bf16_t* x1_buffer(KParams p, int l) { return (l == NL - 1) ? (bf16_t*)(p->ws + WS_H1) : (bf16_t*)p->out; }
__device__ __forceinline__ void phase_rowF(KParams p, int l, int bid, int nb, int wid_s) {
    const int tidx = opaque_tid(wid_s);
    const int lane = tidx & 63, gw = bid * 8 + (tidx >> 6), ngw = nb * 8;
    const float* mod = (const float*)(p->ws + WS_MOD) + (size_t)l * 16 * 6144;
    bf16_t* H2 = (bf16_t*)(p->ws + WS_H2); unsigned char* H2Q = p->ws + WS_H2Q; float* HQS = (float*)(p->ws + WS_HQS);
    const bf16_t* Y = (const bf16_t*)p->out; bf16_t* X1 = x1_buffer(p, l);
    for (int tb = 16 * gw; tb < T; tb += 16 * ngw) {
        const float* m = mod + (size_t)(tb / SEQ) * 6144;
        float gg[16], bb[16], sh[16], sc[16];
        row_load_f32(p->ln1_g + l * D, lane, gg); row_load_f32(p->ln1_b + l * D, lane, bb); row_load_f32(m + 3072, lane, sh); row_load_f32(m + 4096, lane, sc);
        u32x4 na = *(const u32x4*)(Y + (size_t)tb * D + 8 * lane), nb2 = *(const u32x4*)(Y + (size_t)tb * D + 512 + 8 * lane);
#pragma unroll 1
        for (int i = 0; i < 16; ++i) { const int t = tb + i;
            const u32x4 a = na, b = nb2;
            if (i + 1 < 16) { na = *(const u32x4*)(Y + (size_t)(t + 1) * D + 8 * lane); nb2 = *(const u32x4*)(Y + (size_t)(t + 1) * D + 512 + 8 * lane); }
            float v[16];
            v[0] = bf_lo(a.x); v[1] = bf_hi(a.x); v[2] = bf_lo(a.y); v[3] = bf_hi(a.y); v[4] = bf_lo(a.z); v[5] = bf_hi(a.z); v[6] = bf_lo(a.w); v[7] = bf_hi(a.w);
            v[8] = bf_lo(b.x); v[9] = bf_hi(b.x); v[10] = bf_lo(b.y); v[11] = bf_hi(b.y); v[12] = bf_lo(b.z); v[13] = bf_hi(b.z); v[14] = bf_lo(b.w); v[15] = bf_hi(b.w);
            row_normalize(v);
#pragma unroll
            for (int q = 0; q < 16; ++q) v[q] = v[q] * gg[q] + bb[q];
            row_store_bf16(X1 + (size_t)t * D, lane, v);
            row_normalize(v);
#pragma unroll
            for (int q = 0; q < 16; ++q) v[q] = v[q] * (1.0f + sc[q]) + sh[q];
            row_store_bf16(H2 + (size_t)t * D, lane, v);
            float am = 0.f;
#pragma unroll
            for (int q = 0; q < 16; ++q) am = fmaxf(am, fabsf(v[q]));
            am = fmaxf(wave_max(am), 1.0e-20f);
            const float qs = 119.0f * __builtin_amdgcn_rcpf(am);
            unsigned dg[4] = {0u, 0u, 0u, 0u}; int hsum = 0;
#pragma unroll
            for (int q = 0; q < 16; ++q) {
                const int h8 = (int)__builtin_rintf(v[q] * qs); hsum += h8;
                dg[2 * (q >> 3)] |= (unsigned)(((h8 + 8) >> 4) & 15) << (4 * (q & 7));
                dg[2 * (q >> 3) + 1] |= (unsigned)(h8 & 15) << (4 * (q & 7));
            }
            const float hs = wave_sum((float)hsum);
            unsigned char* hq = H2Q + (size_t)t * 1024 + (lane >> 2) * 32 + (lane & 3) * 4;
            *(unsigned*)(hq) = dg[0]; *(unsigned*)(hq + 16) = dg[1]; *(unsigned*)(hq + 512) = dg[2]; *(unsigned*)(hq + 528) = dg[3];
            if (lane == 0) *(f32x2_t*)(HQS + 2 * (size_t)t) = (f32x2_t){am * (U_STEP / 119.0f), 0.5f * hs};
        }
    }
}

__device__ __forceinline__ void store_bf16x4(bf16_t* p, f32x4 v) { *(u32x2*)p = (u32x2){pk2(v.x, v.y), pk2(v.z, v.w)}; }

#define OPQ_S(x) asm volatile("" : "+s"(x))
struct EpiProj {
    static constexpr bool WIDE = true, ROWVAL = false; KParams p;
    __device__ __forceinline__ void rebase() { OPQ_S(p); }
    __device__ __forceinline__ void operator()(int row, int col, f32x4 v0, f32x4 v1) const {
        unsigned char* ws = p->ws;
        bf16_t* proj = (bf16_t*)(ws + WS_PROJ); bf16_t* qlat = (bf16_t*)(ws + WS_QLAT); bf16_t* kvlat = (bf16_t*)(ws + WS_KVLAT);
        float* ssq_q = (float*)(ws + WS_SSQQ); float* ssq_kv = (float*)(ws + WS_SSQKV);
        const int cb = col & ~31;
        const u32x4 w = (u32x4){pk2(v0.x, v0.y), pk2(v0.z, v0.w), pk2(v1.x, v1.y), pk2(v1.z, v1.w)};
        if (cb < 256) *(u32x4*)(qlat + (size_t)row * 256 + col) = w;
        else if (cb < 384) *(u32x4*)(kvlat + (size_t)row * 128 + col - 256) = w;
        else if (cb >= PC_SBQ && cb < PC_KROPE) *(u32x4*)((bf16_t*)(ws + WS_SBX) + (size_t)row * SBX_PITCH + (col - PC_SBQ)) = w;
        else *(u32x4*)(proj + (size_t)row * NPROJ + col) = w;
        if (cb < 384) {
            float s = v0.x * v0.x + v0.y * v0.y + v0.z * v0.z + v0.w * v0.w + v1.x * v1.x + v1.y * v1.y + v1.z * v1.z + v1.w * v1.w;
            s += sxor<16>(s); s = sum_x32(s);
            if ((col & 31) == 0) { if (cb < 256) ssq_q[(size_t)row * 8 + (cb >> 5)] = s; else ssq_kv[(size_t)row * 4 + ((cb - 256) >> 5)] = s; }
        }
    }
};
struct EpiQ {
    static constexpr bool WIDE = false, ROWVAL = true; KParams p;
    __device__ __forceinline__ void rebase() { OPQ_S(p); }
    __device__ __forceinline__ float rowval(int row) const {
        const float* ssq = (const float*)(p->ws + WS_SSQQ);
        const f32x4 sa = *(const f32x4*)(ssq + (size_t)row * 8), sb = *(const f32x4*)(ssq + (size_t)row * 8 + 4);
        return CQ * __builtin_amdgcn_rsqf((((sa.x + sa.y) + (sa.z + sa.w)) + ((sb.x + sb.y) + (sb.z + sb.w))) * (1.0f / 256.0f) + RMS_EPS);
    }
    __device__ __forceinline__ void operator()(int row, int col, f32x4 v0, f32x4 v1, float rs) const {
        unsigned char* ws = p->ws; unsigned char* out = (unsigned char*)p->out;
        bf16_t* q = (bf16_t*)(out + OUT_Q); const float* cosT = (const float*)(ws + WS_COS); const float* sinT = (const float*)(ws + WS_SIN);
        v0 *= rs; v1 *= rs;
        const int cb = col >> 5;
        if (cb % 3 == 2) {
            const int i0 = col & 31;
            const f32x4 cs = *(const f32x4*)(cosT + (size_t)row * 16 + i0), sn = *(const f32x4*)(sinT + (size_t)row * 16 + i0);
            const f32x4 a = v0 * cs - v1 * sn, b = v1 * cs + v0 * sn; v0 = a; v1 = b;
        }
        { const int hq = col / 96, cq = col - 96 * hq; bf16_t* qr = q + ((size_t)hq * T + row) * 96 + cq;
          store_bf16x4(qr, v0); store_bf16x4(qr + 16, v1); }
    }
};
struct EpiKV {
    static constexpr bool WIDE = true, ROWVAL = true, PRE = false; KParams p;
    __device__ __forceinline__ void rebase() { OPQ_S(p); }
    __device__ __forceinline__ float rowval(int row) const {
        const float* ssq = (const float*)(p->ws + WS_SSQKV);
        const f32x4 sa = *(const f32x4*)(ssq + (size_t)row * 4);
        return __builtin_amdgcn_rsqf(((sa.x + sa.y) + (sa.z + sa.w)) * (1.0f / 128.0f) + RMS_EPS);
    }
    __device__ __forceinline__ void operator()(int row, int col, f32x4 v0, f32x4 v1, float rs) const {
        unsigned char* out = (unsigned char*)p->out;
        bf16_t* k = (bf16_t*)(out + OUT_K); bf16_t* v = (bf16_t*)(out + OUT_V);
        v0 *= rs; v1 *= rs;
        const int h = col >> 7, j = col & 127;
        const u32x4 w = (u32x4){pk2(v0.x, v0.y), pk2(v0.z, v0.w), pk2(v1.x, v1.y), pk2(v1.z, v1.w)};
        if (j < 64) *(u32x4*)(k + ((size_t)h * T + row) * 96 + j) = w;
        else *(u32x4*)(v + (((size_t)h * (T / 64) + (row >> 6)) * 8 + ((j - 64) >> 3)) * 512 + (row & 63) * 8) = w;
    }
};
struct EpiY {
    static constexpr bool WIDE = true, ROWVAL = false, PRE = false; KParams p; int l;
    __device__ __forceinline__ void rebase() { OPQ_S(p); OPQ_S(l); }
    __device__ __forceinline__ void operator()(int row, int col, f32x4 v0, f32x4 v1) const {
        bf16_t* y = (bf16_t*)p->out; const float* gate = (const float*)(p->ws + WS_MOD) + (size_t)l * 16 * 6144 + 2048;
        const float* g = gate + (size_t)(row / SEQ) * 6144 + col; bf16_t* yr = y + (size_t)row * D + col;
        const f32x4 g0 = *(const f32x4*)g, g1 = *(const f32x4*)(g + 4);
        f32x4 x0, x1;
        if (l == 0) { const float* xr = p->x + (size_t)row * D + col; x0 = *(const f32x4*)xr; x1 = *(const f32x4*)(xr + 4); }
        else { const bf16_t* xr = (const bf16_t*)(p->ws + WS_X2) + (size_t)row * D + col; const u32x4 a = *(const u32x4*)xr;
               x0 = (f32x4){bf_lo(a.x), bf_hi(a.x), bf_lo(a.y), bf_hi(a.y)}; x1 = (f32x4){bf_lo(a.z), bf_hi(a.z), bf_lo(a.w), bf_hi(a.w)}; }
        const f32x4 o0 = ALPHA * x0 + (1.0f + g0) * v0, o1 = ALPHA * x1 + (1.0f + g1) * v1;
        *(u32x4*)yr = (u32x4){pk2(o0.x, o0.y), pk2(o0.z, o0.w), pk2(o1.x, o1.y), pk2(o1.z, o1.w)};
    }
};
struct EpiBf {
    static constexpr bool WIDE = true, ROWVAL = false; KParams p;
    __device__ __forceinline__ void rebase() { OPQ_S(p); }
    __device__ __forceinline__ void operator()(int row, int col, f32x4 v0, f32x4 v1) const { bf16_t* o = (bf16_t*)(p->ws + WS_PQ);
        const int c = col & 255, d = c & 127;
        const size_t frag = ((((size_t)(col >> 8) * (T / 32) + (row >> 5)) * 2 + (c >> 7)) * 8 + (d >> 4)) * 512 + ((((d >> 3) & 1) * 32 + (row & 31)) * 8);
        *(u32x4*)(o + frag) = (u32x4){pk2(v0.x, v0.y), pk2(v0.z, v0.w), pk2(v1.x, v1.y), pk2(v1.z, v1.w)}; }
};

namespace pg8 {
#define PG8_LAS __attribute__((address_space(3)))
typedef unsigned short bf16_t;
typedef short bf16x8 __attribute__((ext_vector_type(8)));
typedef float f32x4 __attribute__((ext_vector_type(4)));
typedef unsigned u32x4 __attribute__((ext_vector_type(4)));
constexpr int BM = 256, BK = 64, HALF = 128, HTB = HALF * BK * 2  , STAGE_BYTES = 8 * HTB, NXCD = 8, WGM = 8;

__host__ __device__ __forceinline__ int lds_byte(int r, int c) { const int st = (r >> 4) * 2 + (c >> 5), rr = r & 15, cc = c & 31, ob = rr * 64 + cc * 2; return st * 1024 + (ob ^ (((ob >> 9) & 1) << 5)); }
__host__ __device__ __forceinline__ void stage_rc(int b, int& R, int& C) { const int st = b / 1024, sb = b % 1024, swz = sb ^ (((sb >> 9) & 1) << 5); R = (st >> 1) * 16 + swz / 64; C = (st & 1) * 32 + (swz % 64) / 2; }
__host__ __device__ __forceinline__ int perm32(int rho) { const int n = rho >> 4, i = rho & 15; return 8 * (i >> 2) + 4 * n + (i & 3); }

struct Unit { int pm, pn; };
struct Gemm { const bf16_t* A; const bf16_t* Bt; int M, N, K; };

struct StaticOrder {
    int nM, nN, nwg, G, c;
    __host__ __device__ void init(int M, int N, int G_, int c_) { nM = M / BM; nN = N / BM; nwg = nM * nN; G = G_; c = c_; }
    __host__ __device__ bool next(int i, Unit& u) const {
        const long L = (long)i * G + c; if (L >= nwg) return false;
        int wgid = (int)L; { const int q = nwg / NXCD, r = nwg % NXCD, xcd = wgid % NXCD, off = wgid / NXCD; wgid = (xcd < r ? xcd * (q + 1) : r * (q + 1) + (xcd - r) * q) + off; }
        const int nig = WGM * nN, gid = wgid / nig, fm = gid * WGM, gsz = (nM - fm) < WGM ? (nM - fm) : WGM;
        u.pm = fm + ((wgid % nig) % gsz); u.pn = (wgid % nig) / gsz; return true;
    }
    __device__ __forceinline__ void a_ready(const Unit&) const {}
    __device__ __forceinline__ void done(const Unit&) const {}
};
template <class Epi, class Sched, bool ALIGN_EPI = false, bool SP2 = false>
__device__ __forceinline__ void gemm_phase(PG8_LAS unsigned char* lds, const Gemm g, const Sched& S, const Epi& E, int wid_s) {
    const int tid = opaque_tid(wid_s), wid = __builtin_amdgcn_readfirstlane(tid >> 6), lane = tid & 63, wr = wid >> 2, wc = wid & 3, fr = lane & 15, fq = lane >> 4;
    const int K = g.K, nt = K / BK;
    unsigned voffA[2], voffB[2];
#pragma unroll
    for (int i = 0; i < 2; ++i) { int R, C; stage_rc(tid * 16 + i * 8192, R, C); const int Rb = Epi::PERM ? ((R & ~31) + perm32(R & 31)) : R;
        voffA[i] = (unsigned)(R * K + C) * 2u; voffB[i] = (unsigned)(Rb * K + C) * 2u; }
    const size_t kstep = (size_t)(BK * 2);
    const size_t hstep = (size_t)HALF * K * 2;
    const size_t tstep = 2 * hstep;
    const unsigned ldsw = (unsigned)wid * 1024u;
    const unsigned ldsb = (unsigned)__builtin_amdgcn_readfirstlane((int)((unsigned)(__UINTPTR_TYPE__)lds + ldsw));
    int aoff, boff;
#define PG8_SA(b, h) (((b) * 2 + (h)) * HTB)
#define PG8_SB(b, h) ((4 + (b) * 2 + (h)) * HTB)
#define PG8_STAGE(bufoff, gbase, voff) do { _Pragma("unroll") for (int _i = 0; _i < 2; ++_i) { \
        asm volatile("s_mov_b32 m0, %2\n\ts_nop 0\n\tglobal_load_lds_dwordx4 %0, %1" :: "v"((voff)[_i]), "s"((const char*)(gbase)), "s"(ldsb + (unsigned)((bufoff) + _i * 8192)) : "memory", "m0"); } } while (0)
#define PG8_LDA(dst, b, h) do { _Pragma("unroll") for (int m = 0; m < 4; ++m) _Pragma("unroll") for (int k = 0; k < 2; ++k) dst[m][k] = *(const PG8_LAS bf16x8*)(lds + PG8_SA(b, h) + aoff + m * 2048 + k * 1024); } while (0)
#define PG8_LDB(dst, b, h) do { _Pragma("unroll") for (int n = 0; n < 2; ++n) _Pragma("unroll") for (int k = 0; k < 2; ++k) dst[n][k] = *(const PG8_LAS bf16x8*)(lds + PG8_SB(b, h) + boff + n * 2048 + k * 1024); } while (0)
#define PG8_MMA(ai, bj, At, Bt) do { __builtin_amdgcn_s_setprio(1); _Pragma("unroll") for (int m = 0; m < 4; ++m) _Pragma("unroll") for (int n = 0; n < 2; ++n) _Pragma("unroll") for (int k = 0; k < 2; ++k) \
        acc[ai][bj][m][n] = __builtin_amdgcn_mfma_f32_16x16x32_bf16(Bt[n][k], At[m][k], acc[ai][bj][m][n], 0, 0, 0); __builtin_amdgcn_s_setprio(0); } while (0)
#define PG8_WAIT_V(n) asm volatile("s_waitcnt vmcnt(" #n ")" ::: "memory")
#define PG8_WAIT_L(n) asm volatile("s_waitcnt lgkmcnt(" #n ")" ::: "memory")
#define PG8_BAR __builtin_amdgcn_s_barrier()
#define PG8_SCHED __builtin_amdgcn_sched_barrier(0)
    Unit cur, nxt; int ui = 0;
    if (!S.next(0, cur)) return;
    f32x4 acc[2][2][4][2];
#pragma unroll
    for (int a = 0; a < 2; ++a)
#pragma unroll
        for (int b = 0; b < 2; ++b)
#pragma unroll
            for (int m = 0; m < 4; ++m)
#pragma unroll
                for (int n = 0; n < 2; ++n) acc[a][b][m][n] = (f32x4){0.f, 0.f, 0.f, 0.f};
    bf16x8 At[4][2], B0[2][2], B1[2][2];
    const char* cA = (const char*)g.A + (size_t)cur.pm * tstep; const char* cB = (const char*)g.Bt + (size_t)cur.pn * tstep;
    S.a_ready(cur);
    if constexpr (SP2) {
        PG8_STAGE(PG8_SB(0, 0), cB, voffB); PG8_STAGE(PG8_SB(0, 1), cB + hstep, voffB); PG8_STAGE(PG8_SA(0, 0), cA, voffA); PG8_STAGE(PG8_SA(0, 1), cA + hstep, voffA);
        if (wr == 1) PG8_BAR;
        PG8_WAIT_V(2); PG8_BAR;
        PG8_STAGE(PG8_SB(1, 0), cB + kstep, voffB); PG8_STAGE(PG8_SA(1, 0), cA + kstep, voffA); PG8_STAGE(PG8_SB(1, 1), cB + hstep + kstep, voffB);
        PG8_WAIT_V(6); PG8_BAR;
    } else {
        PG8_STAGE(PG8_SB(0, 0), cB, voffB); PG8_STAGE(PG8_SA(0, 0), cA, voffA); PG8_STAGE(PG8_SB(0, 1), cB + hstep, voffB); PG8_STAGE(PG8_SA(0, 1), cA + hstep, voffA);
        if (wr == 1) PG8_BAR;
        PG8_WAIT_V(4); PG8_BAR;
        PG8_STAGE(PG8_SB(1, 0), cB + kstep, voffB); PG8_STAGE(PG8_SA(1, 0), cA + kstep, voffA); PG8_STAGE(PG8_SB(1, 1), cB + hstep + kstep, voffB);
        PG8_WAIT_V(6); PG8_BAR;
    }
    { int fr2 = fr, fq2 = fq; asm volatile("" : "+v"(fr2), "+v"(fq2)); aoff = lds_byte(wr * 64 + fr2, fq2 * 8); boff = lds_byte(wc * 32 + fr2, fq2 * 8); }
    for (;;) {
        const bool has_next = S.next(ui + 1, nxt);
        const char* nA = has_next ? (const char*)g.A + (size_t)nxt.pm * tstep : cA; const char* nB = has_next ? (const char*)g.Bt + (size_t)nxt.pn * tstep : cB;
        for (int t = 0; t < nt; t += 2) {
            const bool last = (t == nt - 2);
            const char* a1 = cA + (size_t)(t + 1) * kstep;
            const char* a2 = last ? nA : cA + (size_t)(t + 2) * kstep; const char* b2 = last ? nB : cB + (size_t)(t + 2) * kstep;
            const char* a3 = a2 + kstep; const char* b3 = b2 + kstep;
            if (last && has_next) S.a_ready(nxt);
            if constexpr (SP2) {
            PG8_LDB(B0, 0, 0); PG8_LDB(B1, 0, 1); PG8_SCHED; PG8_LDA(At, 0, 0); PG8_STAGE(PG8_SA(1, 1), a1 + hstep, voffA);
            PG8_WAIT_V(8); PG8_WAIT_L(0); PG8_BAR; PG8_MMA(0, 0, At, B0); PG8_MMA(0, 1, At, B1); PG8_BAR; PG8_SCHED;
            PG8_LDA(At, 0, 1); PG8_STAGE(PG8_SB(0, 0), b2, voffB); PG8_STAGE(PG8_SB(0, 1), b2 + hstep, voffB); PG8_STAGE(PG8_SA(0, 0), a2, voffA);
            PG8_WAIT_V(8); PG8_WAIT_L(0); PG8_BAR; PG8_MMA(1, 0, At, B0); PG8_MMA(1, 1, At, B1); PG8_BAR; PG8_SCHED;
            PG8_LDB(B0, 1, 0); PG8_LDB(B1, 1, 1); PG8_SCHED; PG8_LDA(At, 1, 0); PG8_STAGE(PG8_SA(0, 1), a2 + hstep, voffA);
            PG8_WAIT_V(8); PG8_WAIT_L(0); PG8_BAR; PG8_MMA(0, 0, At, B0); PG8_MMA(0, 1, At, B1); PG8_BAR; PG8_SCHED;
            PG8_LDA(At, 1, 1); PG8_STAGE(PG8_SB(1, 0), b3, voffB); PG8_STAGE(PG8_SB(1, 1), b3 + hstep, voffB); PG8_STAGE(PG8_SA(1, 0), a3, voffA);
            PG8_WAIT_V(8); PG8_WAIT_L(0); PG8_BAR; PG8_MMA(1, 0, At, B0); PG8_MMA(1, 1, At, B1); PG8_BAR; PG8_SCHED;
            } else {
            PG8_LDB(B0, 0, 0); PG8_SCHED; PG8_LDA(At, 0, 0); PG8_STAGE(PG8_SA(1, 1), a1 + hstep, voffA);
            PG8_WAIT_L(8); PG8_BAR; PG8_WAIT_L(0); PG8_MMA(0, 0, At, B0); PG8_BAR; PG8_SCHED;
            PG8_LDB(B1, 0, 1); PG8_STAGE(PG8_SB(0, 0), b2, voffB);
            PG8_BAR; PG8_WAIT_L(0); PG8_MMA(0, 1, At, B1); PG8_BAR;
            PG8_LDA(At, 0, 1); PG8_STAGE(PG8_SA(0, 0), a2, voffA);
            PG8_BAR; PG8_WAIT_L(0); PG8_MMA(1, 0, At, B0); PG8_BAR; PG8_SCHED;
            PG8_STAGE(PG8_SB(0, 1), b2 + hstep, voffB);
            PG8_WAIT_V(6); PG8_BAR; PG8_MMA(1, 1, At, B1); PG8_BAR;
            PG8_LDB(B0, 1, 0); PG8_SCHED; PG8_LDA(At, 1, 0); PG8_STAGE(PG8_SA(0, 1), a2 + hstep, voffA);
            PG8_WAIT_L(8); PG8_BAR; PG8_WAIT_L(0); PG8_MMA(0, 0, At, B0); PG8_BAR; PG8_SCHED;
            PG8_LDB(B1, 1, 1); PG8_STAGE(PG8_SB(1, 0), b3, voffB);
            PG8_BAR; PG8_WAIT_L(0); PG8_MMA(0, 1, At, B1); PG8_BAR;
            PG8_LDA(At, 1, 1); PG8_STAGE(PG8_SA(1, 0), a3, voffA);
            PG8_BAR; PG8_WAIT_L(0); PG8_MMA(1, 0, At, B0); PG8_BAR; PG8_SCHED;
            PG8_STAGE(PG8_SB(1, 1), b3 + hstep, voffB);
            PG8_WAIT_V(6); PG8_BAR; PG8_MMA(1, 1, At, B1); PG8_BAR;
            }
        }
        if constexpr (ALIGN_EPI) { if (wr == 0) PG8_BAR; }
        if constexpr (!Epi::AFTER_DRAIN) { E(acc, cur, wr, wc, fr, fq); S.done(cur); }
        if (!has_next) break;
#pragma unroll
        for (int a = 0; a < 2; ++a)
#pragma unroll
            for (int b = 0; b < 2; ++b)
#pragma unroll
                for (int m = 0; m < 4; ++m)
#pragma unroll
                    for (int n = 0; n < 2; ++n) acc[a][b][m][n] = (f32x4){0.f, 0.f, 0.f, 0.f};
        cur = nxt; cA = nA; cB = nB; ++ui;
        if constexpr (ALIGN_EPI) { if (wr == 1) PG8_BAR; }
    }
    PG8_WAIT_V(0);
    if constexpr (!ALIGN_EPI) { if (wr == 0) PG8_BAR; }
    PG8_BAR;
    if constexpr (Epi::AFTER_DRAIN) { E.fused(acc, cur, wr, wc, fr, fq, lds, wid, lane); S.done(cur); }
#undef PG8_SA
#undef PG8_SB
#undef PG8_STAGE
#undef PG8_LDA
#undef PG8_LDB
#undef PG8_MMA
#undef PG8_WAIT_V
#undef PG8_WAIT_L
#undef PG8_BAR
#undef PG8_SCHED
}
}

template <class E> struct Pg8Epi {
    static constexpr bool PERM = E::WIDE, AFTER_DRAIN = false; E e;
    __device__ __forceinline__ void operator()(const pg8::f32x4 (&acc)[2][2][4][2], const pg8::Unit& u, int wr, int wc, int fr, int fq) const {
        { int ln; asm volatile("v_mbcnt_lo_u32_b32 %0, -1, 0\n\tv_mbcnt_hi_u32_b32 %0, -1, %0" : "=v"(ln)); fr = ln & 15; fq = ln >> 4; }
        E e = this->e; e.rebase();
        if constexpr (E::ROWVAL) {
            float rv[2][4];
#pragma unroll
            for (int ai = 0; ai < 2; ++ai)
#pragma unroll
                for (int m = 0; m < 4; ++m) rv[ai][m] = e.rowval(u.pm * 256 + ai * 128 + wr * 64 + m * 16 + fr);
#pragma unroll
            for (int ai = 0; ai < 2; ++ai)
#pragma unroll
                for (int m = 0; m < 4; ++m)
#pragma unroll
                    for (int bj = 0; bj < 2; ++bj) { e(u.pm * 256 + ai * 128 + wr * 64 + m * 16 + fr, u.pn * 256 + bj * 128 + wc * 32 + (E::WIDE ? 8 : 4) * fq, acc[ai][bj][m][0], acc[ai][bj][m][1], rv[ai][m]); asm volatile("" ::: "memory"); }
        } else {
#pragma unroll
            for (int ai = 0; ai < 2; ++ai)
#pragma unroll
                for (int m = 0; m < 4; ++m)
#pragma unroll
                    for (int bj = 0; bj < 2; ++bj) { e(u.pm * 256 + ai * 128 + wr * 64 + m * 16 + fr, u.pn * 256 + bj * 128 + wc * 32 + (E::WIDE ? 8 : 4) * fq, acc[ai][bj][m][0], acc[ai][bj][m][1]); asm volatile("" ::: "memory"); }
        }
    }
};
template <class E> __device__ __forceinline__ void gemm_fast(LAS unsigned char* lds, const bf16_t* A, const bf16_t* Bt, int M, int N, int K, const E& e, int bid, int nb, int wid_s) {
    asm volatile("" : "+s"(nb), "+s"(bid));
    pg8::Gemm g{A, Bt, M, N, K}; pg8::StaticOrder S; S.init(M, N, nb, bid);
    Pg8Epi<E> pe{e};
    pg8::gemm_phase<Pg8Epi<E>, pg8::StaticOrder, true, true>(lds, g, S, pe, wid_s);
}

__device__ __forceinline__ void phase_conv_krope(KParams p, int l, int bid, int nb, int wid_s) {
    const int tidx = opaque_tid(wid_s);
    const int lane = tidx & 63, gw = bid * 8 + (tidx >> 6), ngw = nb * 8;
    const bf16_t* proj = (const bf16_t*)(p->ws + WS_PROJ); bf16_t* cc = (bf16_t*)(p->ws + WS_CONCAT); bf16_t* K = (bf16_t*)((unsigned char*)p->out + OUT_K);
    const float* cosT = (const float*)(p->ws + WS_COS); const float* sinT = (const float*)(p->ws + WS_SIN);
    const int c0 = 4 * lane;
    const float* cw = p->conv_w + (size_t)l * 3 * 256 + c0;
    const f32x4 w0 = *(const f32x4*)(cw), w1 = *(const f32x4*)(cw + 256), w2 = *(const f32x4*)(cw + 512);
    const int tsub = lane >> 3, part = lane & 7, half = part >> 2, i0 = 4 * (part & 3);
    for (int ch = gw; ch < T / 16; ch += ngw) {
        const int t0 = ch * 16;
        const bool seq0 = (t0 % SEQ) == 0; const int tm1 = seq0 ? t0 : t0 - 1, tm2 = seq0 ? t0 : t0 - 2;
        const u32x2 pa1 = *(const u32x2*)(proj + (size_t)tm1 * NPROJ + PC_CC + c0), pb1 = *(const u32x2*)(proj + (size_t)tm1 * NPROJ + PC_CH + c0);
        const u32x2 pa2 = *(const u32x2*)(proj + (size_t)tm2 * NPROJ + PC_CC + c0), pb2 = *(const u32x2*)(proj + (size_t)tm2 * NPROJ + PC_CH + c0);
        u32x2 a[16], b[16], g[16], x1[2], x2[2]; f32x4 cs[2], sn[2];
#pragma unroll
        for (int q = 0; q < 16; ++q) { const bf16_t* pr = proj + (size_t)(t0 + q) * NPROJ;
            a[q] = *(const u32x2*)(pr + PC_CC + c0); b[q] = *(const u32x2*)(pr + PC_CH + c0); g[q] = *(const u32x2*)(pr + PC_CB + c0); }
#pragma unroll
        for (int r = 0; r < 2; ++r) { const size_t t = (size_t)(t0 + 8 * r + tsub); const bf16_t* pr = proj + t * NPROJ;
            x1[r] = *(const u32x2*)(pr + PC_KROPE + i0); x2[r] = *(const u32x2*)(pr + PC_KROPE + 16 + i0);
            cs[r] = *(const f32x4*)(cosT + t * 16 + i0); sn[r] = *(const f32x4*)(sinT + t * 16 + i0); }
        const float z = seq0 ? 0.f : 1.f;
        f32x4 um1 = (f32x4){bf_lo(pa1.x) * bf_lo(pb1.x), bf_hi(pa1.x) * bf_hi(pb1.x), bf_lo(pa1.y) * bf_lo(pb1.y), bf_hi(pa1.y) * bf_hi(pb1.y)} * z;
        f32x4 um2 = (f32x4){bf_lo(pa2.x) * bf_lo(pb2.x), bf_hi(pa2.x) * bf_hi(pb2.x), bf_lo(pa2.y) * bf_lo(pb2.y), bf_hi(pa2.y) * bf_hi(pb2.y)} * z;
#pragma unroll
        for (int q = 0; q < 16; ++q) { const size_t t = (size_t)(t0 + q);
            const f32x4 u = {bf_lo(a[q].x) * bf_lo(b[q].x), bf_hi(a[q].x) * bf_hi(b[q].x), bf_lo(a[q].y) * bf_lo(b[q].y), bf_hi(a[q].y) * bf_hi(b[q].y)};
            const f32x4 y = w0 * um2 + w1 * um1 + w2 * u;
            um2 = um1; um1 = u;
            *(u32x2*)(cc + t * D + 512 + c0) = (u32x2){pk2(bf_lo(g[q].x) * y.x, bf_hi(g[q].x) * y.y), pk2(bf_lo(g[q].y) * y.z, bf_hi(g[q].y) * y.w)}; }
#pragma unroll
        for (int r = 0; r < 2; ++r) { const size_t t = (size_t)(t0 + 8 * r + tsub);
            const f32x4 xa = {bf_lo(x1[r].x), bf_hi(x1[r].x), bf_lo(x1[r].y), bf_hi(x1[r].y)}, xb = {bf_lo(x2[r].x), bf_hi(x2[r].x), bf_lo(x2[r].y), bf_hi(x2[r].y)};
            const f32x4 o = half ? (xb * cs[r] + xa * sn[r]) : (xa * cs[r] - xb * sn[r]);
            const u32x2 w = {pk2(o.x, o.y), pk2(o.z, o.w)};
#pragma unroll
            for (int hd = 0; hd < 8; ++hd) *(u32x2*)(K + ((size_t)hd * T + t) * 96 + 64 + 4 * part) = w; }
    }
}

typedef __bf16 bf16x2v_t __attribute__((ext_vector_type(2)));
__device__ __forceinline__ unsigned cvtpk(float lo, float hi) { const f32x2_t v = {lo, hi}; const bf16x2v_t b = __builtin_convertvector(v, bf16x2v_t); return __builtin_bit_cast(unsigned, b); }
__device__ __forceinline__ float fexp2(float x) { return __builtin_amdgcn_exp2f(x); }
__device__ __forceinline__ float flog2(float x) { return __builtin_amdgcn_logf(x); }
constexpr int AK_PITCH = 208, AV_PITCH = 144;
constexpr int AK_BYTES = 64 * AK_PITCH, AV_BYTES = 64 * AV_PITCH;
constexpr int ATT_K0 = 0, ATT_V0 = 2 * AK_BYTES, ATT_LDS = 2 * AK_BYTES + 2 * AV_BYTES;
__device__ __forceinline__ int key_slot(int key) { return (key & ~12) | ((key & 4) << 1) | ((key & 8) >> 1); }
template <int DK> struct AttStage { u32x4 k0, k1, v; };
template <int DK> __device__ __forceinline__ void att_load(AttStage<DK>& st, const bf16_t* Kg, int kpitch, const bf16_t* Vg, int vpitch, int tid) {
    constexpr int KCH = DK / 8;
    { const int key = tid / KCH, part = tid % KCH; st.k0 = *(const u32x4*)(Kg + (size_t)key * kpitch + part * 8); }
    if (DK == 96) { if (tid < 256) { const int c = tid + 512, key = c / KCH, part = c % KCH; st.k1 = *(const u32x4*)(Kg + (size_t)key * kpitch + part * 8); } }
    { const int key = tid & 63, dch = tid >> 6; st.v = *(const u32x4*)(Vg + (size_t)key * vpitch + dch * 8); }
}
template <int DK> __device__ __forceinline__ void att_store(const AttStage<DK>& st, LAS unsigned char* kbuf, LAS unsigned char* vbuf, int tid) {
    constexpr int KCH = DK / 8;
    { const int key = tid / KCH, part = tid % KCH; *(LAS u32x4*)(kbuf + key * AK_PITCH + part * 16) = st.k0; }
    if (DK == 96) { if (tid < 256) { const int c = tid + 512, key = c / KCH, part = c % KCH; *(LAS u32x4*)(kbuf + key * AK_PITCH + part * 16) = st.k1; } }
    { const int key = tid & 63, dch = tid >> 6; LAS unsigned char* vp = vbuf + (dch * 8) * AV_PITCH + key_slot(key) * 2;
      const unsigned w0 = st.v.x, w1 = st.v.y, w2 = st.v.z, w3 = st.v.w;
      *(LAS bf16_t*)(vp + 0 * AV_PITCH) = (bf16_t)(w0 & 0xffffu); *(LAS bf16_t*)(vp + 1 * AV_PITCH) = (bf16_t)(w0 >> 16);
      *(LAS bf16_t*)(vp + 2 * AV_PITCH) = (bf16_t)(w1 & 0xffffu); *(LAS bf16_t*)(vp + 3 * AV_PITCH) = (bf16_t)(w1 >> 16);
      *(LAS bf16_t*)(vp + 4 * AV_PITCH) = (bf16_t)(w2 & 0xffffu); *(LAS bf16_t*)(vp + 5 * AV_PITCH) = (bf16_t)(w2 >> 16);
      *(LAS bf16_t*)(vp + 6 * AV_PITCH) = (bf16_t)(w3 & 0xffffu); *(LAS bf16_t*)(vp + 7 * AV_PITCH) = (bf16_t)(w3 >> 16); }
}
template <int DK> __device__ __forceinline__ void att_load_k(AttStage<DK>& st, const bf16_t* Kg, int kpitch, int tid) {
    constexpr int KCH = DK / 8;
    { const int key = tid / KCH, part = tid % KCH; st.k0 = *(const u32x4*)(Kg + (size_t)key * kpitch + part * 8); }
    if (DK == 96) { if (tid < 256) { const int c = tid + 512, key = c / KCH, part = c % KCH; st.k1 = *(const u32x4*)(Kg + (size_t)key * kpitch + part * 8); } }
}
__device__ __forceinline__ void att_load_kc(AttStage<96>& st, const bf16_t* Kg, int tid) {
    st.k0 = *(const u32x4*)(Kg + 8u * (unsigned)tid);
    if (tid < 256) st.k1 = *(const u32x4*)(Kg + 8u * (unsigned)(tid + 512));
}
template <int DK> __device__ __forceinline__ void att_load_v(AttStage<DK>& st, const bf16_t* Vg, int vpitch, int tid) {
    const unsigned key = (unsigned)tid & 63u, dch = (unsigned)tid >> 6; st.v = *(const u32x4*)(Vg + (key * (unsigned)vpitch + dch * 8u));
}
template <int DK> __device__ __forceinline__ void att_store_k(const AttStage<DK>& st, LAS unsigned char* kbuf, int tid) {
    constexpr int KCH = DK / 8;
    { const int key = tid / KCH, part = tid % KCH; *(LAS u32x4*)(kbuf + key * AK_PITCH + part * 16) = st.k0; }
    if (DK == 96) { if (tid < 256) { const int c = tid + 512, key = c / KCH, part = c % KCH; *(LAS u32x4*)(kbuf + key * AK_PITCH + part * 16) = st.k1; } }
}
template <int DK> __device__ __forceinline__ void att_store_v(const AttStage<DK>& st, LAS unsigned char* vbuf, int tid) {
    const int key = tid & 63, dch = tid >> 6; LAS unsigned char* vp = vbuf + (dch * 8) * AV_PITCH + key_slot(key) * 2;
    const unsigned w0 = st.v.x, w1 = st.v.y, w2 = st.v.z, w3 = st.v.w;
    *(LAS bf16_t*)(vp + 0 * AV_PITCH) = (bf16_t)(w0 & 0xffffu); *(LAS bf16_t*)(vp + 1 * AV_PITCH) = (bf16_t)(w0 >> 16);
    *(LAS bf16_t*)(vp + 2 * AV_PITCH) = (bf16_t)(w1 & 0xffffu); *(LAS bf16_t*)(vp + 3 * AV_PITCH) = (bf16_t)(w1 >> 16);
    *(LAS bf16_t*)(vp + 4 * AV_PITCH) = (bf16_t)(w2 & 0xffffu); *(LAS bf16_t*)(vp + 5 * AV_PITCH) = (bf16_t)(w2 >> 16);
    *(LAS bf16_t*)(vp + 6 * AV_PITCH) = (bf16_t)(w3 & 0xffffu); *(LAS bf16_t*)(vp + 7 * AV_PITCH) = (bf16_t)(w3 >> 16);
}
__device__ __forceinline__ bf16x8 pack8(const f32x16& p, int base) {
    u32x4 w; w.x = cvtpk(p[base + 0], p[base + 1]); w.y = cvtpk(p[base + 2], p[base + 3]); w.z = cvtpk(p[base + 4], p[base + 5]); w.w = cvtpk(p[base + 6], p[base + 7]);
    return __builtin_bit_cast(bf16x8, w);
}
__device__ __forceinline__ void att_write_out(bf16_t* orow, const f32x16& o0, const f32x16& o1, float scale, int hi) {
#pragma unroll
    for (int g = 0; g < 4; ++g) {
        *(u32x2*)(orow + 8 * g + 4 * hi) = (u32x2){cvtpk(o0[4 * g] * scale, o0[4 * g + 1] * scale), cvtpk(o0[4 * g + 2] * scale, o0[4 * g + 3] * scale)};
        *(u32x2*)(orow + 32 + 8 * g + 4 * hi) = (u32x2){cvtpk(o1[4 * g] * scale, o1[4 * g + 1] * scale), cvtpk(o1[4 * g + 2] * scale, o1[4 * g + 3] * scale)};
    }
}
#define ZERO16 (f32x16){0.f, 0.f, 0.f, 0.f, 0.f, 0.f, 0.f, 0.f, 0.f, 0.f, 0.f, 0.f, 0.f, 0.f, 0.f, 0.f}
__device__ __forceinline__ f32x16 zero16_opq() { float z; asm volatile("v_mov_b32 %0, 0" : "=v"(z)); return (f32x16){z, z, z, z, z, z, z, z, z, z, z, z, z, z, z, z}; }

#define SBAR() __builtin_amdgcn_sched_barrier(0)
#define PIN1(x) asm volatile("" : "+v"(x))
#define MFMA32(a, b, c) __builtin_amdgcn_mfma_f32_32x32x16_bf16(a, b, c, 0, 0, 0)
#define MLA_FA(X, B, W0, W1) { sa += X[B] + X[B + 1]; sb += X[B + 2] + X[B + 3]; W0 = cvtpk(X[B], X[B + 1]); W1 = cvtpk(X[B + 2], X[B + 3]); PIN1(sa); PIN1(sb); PIN1(W0); PIN1(W1); }
#define MLA_FB(X, B) { X[B] = fexp2(X[B] - m); X[B + 1] = fexp2(X[B + 1] - m); X[B + 2] = fexp2(X[B + 2] - m); X[B + 3] = fexp2(X[B + 3] - m); PIN1(X[B]); PIN1(X[B + 1]); PIN1(X[B + 2]); PIN1(X[B + 3]); }
#define MLA_ROWMAX(C0, C1, MX) { float mxa = fmaxf(fmaxf(C0[0], C0[1]), C1[0]), mxb = fmaxf(fmaxf(C0[2], C0[3]), C1[1]); mxa = fmaxf(fmaxf(mxa, C1[2]), C1[3]); \
        _Pragma("unroll") for (int r = 4; r < 16; r += 4) { mxa = fmaxf(fmaxf(mxa, C0[r]), C0[r + 1]); mxb = fmaxf(fmaxf(mxb, C0[r + 2]), C0[r + 3]); mxa = fmaxf(fmaxf(mxa, C1[r]), C1[r + 1]); mxb = fmaxf(fmaxf(mxb, C1[r + 2]), C1[r + 3]); } \
        MX = max_x32(fmaxf(mxa, mxb)); }
#define KA(S, H) (*(const LAS bf16x8*)(ka + 32 * (S) + (H) * 32 * AK_PITCH))
#define VA(S, H) (*(const LAS bf16x8*)(va + 32 * (S) + (H) * 32 * AV_PITCH))
#define MLA_PHASE_A(C0, C1, P0, P1, FILL) { \
        float sa = 0.f, sb = 0.f; \
        bf16x8 e0 = KA(0, 0), e1 = KA(0, 1); \
        C0 = MFMA32(e0, qf[0], ZERO16); e0 = KA(1, 0); if (FILL) MLA_FA(P0, 0, w[0], w[1]) SBAR(); C1 = MFMA32(e1, qf[0], ZERO16); e1 = KA(1, 1); if (FILL) MLA_FA(P0, 4, w[2], w[3]) SBAR(); \
        C0 = MFMA32(e0, qf[1], C0); e0 = KA(2, 0); if (FILL) MLA_FA(P0, 8, w[4], w[5]) SBAR(); C1 = MFMA32(e1, qf[1], C1); e1 = KA(2, 1); if (FILL) MLA_FA(P0, 12, w[6], w[7]) SBAR(); \
        C0 = MFMA32(e0, qf[2], C0); e0 = KA(3, 0); if (FILL) MLA_FA(P1, 0, w[8], w[9]) SBAR(); C1 = MFMA32(e1, qf[2], C1); e1 = KA(3, 1); if (FILL) MLA_FA(P1, 4, w[10], w[11]) SBAR(); \
        C0 = MFMA32(e0, qf[3], C0); e0 = KA(4, 0); if (FILL) MLA_FA(P1, 8, w[12], w[13]) SBAR(); C1 = MFMA32(e1, qf[3], C1); e1 = KA(4, 1); if (FILL) MLA_FA(P1, 12, w[14], w[15]) SBAR(); \
        C0 = MFMA32(e0, qf[4], C0); e0 = KA(5, 0); SBAR(); C1 = MFMA32(e1, qf[4], C1); e1 = KA(5, 1); SBAR(); \
        C0 = MFMA32(e0, qf[5], C0); SBAR(); C1 = MFMA32(e1, qf[5], C1); SBAR(); \
        if (FILL) l += sa + sb; }
#define MLA_WFRAG(i) __builtin_bit_cast(bf16x8, (u32x4){w[4 * (i)], w[4 * (i) + 1], w[4 * (i) + 2], w[4 * (i) + 3]})
#define MLA_PHASE_B(C0, C1, EXPS) { \
        bf16x8 e0 = VA(0, 0), e1 = VA(0, 1); \
        o0 = MFMA32(e0, MLA_WFRAG(0), o0); e0 = VA(1, 0); if (EXPS) MLA_FB(C0, 0) SBAR(); o1 = MFMA32(e1, MLA_WFRAG(0), o1); e1 = VA(1, 1); if (EXPS) MLA_FB(C0, 4) SBAR(); \
        o0 = MFMA32(e0, MLA_WFRAG(1), o0); e0 = VA(2, 0); if (EXPS) MLA_FB(C0, 8) SBAR(); o1 = MFMA32(e1, MLA_WFRAG(1), o1); e1 = VA(2, 1); if (EXPS) MLA_FB(C0, 12) SBAR(); \
        o0 = MFMA32(e0, MLA_WFRAG(2), o0); e0 = VA(3, 0); if (EXPS) MLA_FB(C1, 0) SBAR(); o1 = MFMA32(e1, MLA_WFRAG(2), o1); e1 = VA(3, 1); if (EXPS) MLA_FB(C1, 4) SBAR(); \
        o0 = MFMA32(e0, MLA_WFRAG(3), o0); if (EXPS) MLA_FB(C1, 8) SBAR(); o1 = MFMA32(e1, MLA_WFRAG(3), o1); if (EXPS) MLA_FB(C1, 12) SBAR(); }
#define MLA_STEP(C0, C1, P0, P1) { \
        const LAS unsigned char* ka = lds + ATT_K0 + (t & 1) * AK_BYTES + r32 * AK_PITCH + hi * 16; const LAS unsigned char* va = lds + ATT_V0 + ((t + 1) & 1) * AV_BYTES + r32 * AV_PITCH + hi * 16; \
        unsigned w[16]; \
        if (t == 0) {                         \
            MLA_PHASE_A(C0, C1, P0, P1, false) \
            float mx; MLA_ROWMAX(C0, C1, mx) m = mx; \
            _Pragma("unroll") for (int r = 0; r < 16; ++r) { C0[r] = fexp2(C0[r] - m); C1[r] = fexp2(C1[r] - m); } \
        } else if (t <= my_last) {            \
            MLA_PHASE_A(C0, C1, P0, P1, true) \
            float mx; MLA_ROWMAX(C0, C1, mx) \
            float alpha = 1.0f; bool resc = false; \
            if (__builtin_expect(__any(mx > m), 0)) { const float mn = fmaxf(m, mx); alpha = fexp2(m - mn); m = mn; l *= alpha; resc = true; }     \
            MLA_PHASE_B(C0, C1, true) \
            if (resc) { o0 *= alpha; o1 *= alpha; } \
        } else if (t == my_last + 1) {        \
            float sa = 0.f, sb = 0.f; \
            MLA_FA(P0, 0, w[0], w[1]) MLA_FA(P0, 4, w[2], w[3]) MLA_FA(P0, 8, w[4], w[5]) MLA_FA(P0, 12, w[6], w[7]) MLA_FA(P1, 0, w[8], w[9]) MLA_FA(P1, 4, w[10], w[11]) MLA_FA(P1, 8, w[12], w[13]) MLA_FA(P1, 12, w[14], w[15]) \
            l += sa + sb; \
            MLA_PHASE_B(C0, C1, false) \
        } }
#define MLA_STEP_S(C0, C1, P0, P1) { \
        const LAS unsigned char* ka = lds + ATT_K0 + (t & 1) * AK_BYTES + r32 * AK_PITCH + hi * 16; const LAS unsigned char* va = lds + ATT_V0 + ((t + 1) & 1) * AV_BYTES + r32 * AV_PITCH + hi * 16; \
        unsigned w[16]; \
        MLA_PHASE_A(C0, C1, P0, P1, true) \
        float mx; MLA_ROWMAX(C0, C1, mx) \
        float alpha = 1.0f; bool resc = false; \
        if (__builtin_expect(__any(mx > m), 0)) { const float mn = fmaxf(m, mx); alpha = fexp2(m - mn); m = mn; l *= alpha; resc = true; } \
        MLA_PHASE_B(C0, C1, true) \
        if (resc) { o0 *= alpha; o1 *= alpha; } }
__device__ __forceinline__ void phase_mla(KParams p, LAS unsigned char* lds, int bid, int nb, int wid_s) {
    const int tid = opaque_tid(wid_s), lane = tid & 63, wave = __builtin_amdgcn_readfirstlane(tid >> 6), r32 = lane & 31, hi = lane >> 5;
    const bf16_t* Q = (const bf16_t*)((unsigned char*)p->out + OUT_Q); const bf16_t* K = (const bf16_t*)((unsigned char*)p->out + OUT_K); const bf16_t* V = (const bf16_t*)((unsigned char*)p->out + OUT_V);
    bf16_t* cc = (bf16_t*)(p->ws + WS_CONCAT);
    for (int u = bid; u < 1024; u += nb) {
        const int slot = (u >> 8) & 3, ub = u & 255, v = (((ub & 7) * 16 + (ub >> 4)) << 1) | ((ub >> 3) & 1), bh = v >> 1, b = bh >> 3, h = bh & 7;
        const int qb = (v & 1) ? ((slot == 0) ? 6 : (slot == 1) ? 1 : (slot == 2) ? 5 : 2) : ((slot == 0) ? 7 : (slot == 1) ? 0 : (slot == 2) ? 4 : 3);
        const int q0 = qb * 256, nt = 4 * qb + 4, my_last = (q0 + 32 * wave) >> 6;
        const bf16_t* Kg = K + ((size_t)h * T + b * SEQ) * 96; const bf16_t* Vg = V + ((size_t)h * T + b * SEQ) * 64;
        const bf16_t* qrow = Q + (unsigned)((h * T + b * SEQ + q0 + 32 * wave + r32) * 96 + hi * 8);
        bf16x8 qf[6];
#pragma unroll
        for (int s = 0; s < 6; ++s) qf[s] = *(const bf16x8*)(qrow + 16 * s);
        f32x16 o0 = zero16_opq(), o1 = o0, pA0, pA1, pB0, pB1; float m = -1.0e30f, l = 0.f;
        AttStage<96> st;
        att_load_kc(st, Kg, tid);
        att_store_k<96>(st, lds + ATT_K0, tid);
        __syncthreads();
#define MLA_TILE_X(STEP, TT, C0, C1, P0, P1) { const int t = (TT); \
            {   const int tk = t + 1 < nt ? t + 1 : nt - 1, tv = t < nt ? t : nt - 1;     \
                att_load_kc(st, Kg + (size_t)tk * 64 * 96, tid); st.v = *(const u32x4*)(Vg + (size_t)tv * 64 * 64 + 8u * (unsigned)tid); } \
            STEP(C0, C1, P0, P1) \
            att_store_k<96>(st, lds + ATT_K0 + ((t + 1) & 1) * AK_BYTES, tid); \
            att_store_v<96>(st, lds + ATT_V0 + (t & 1) * AV_BYTES, tid); \
            __syncthreads(); }
        int tt = 2;
        MLA_TILE_X(MLA_STEP, 0, pA0, pA1, pB0, pB1)
        MLA_TILE_X(MLA_STEP, 1, pB0, pB1, pA0, pA1)
        for (; tt + 1 <= my_last; tt += 2) {
            MLA_TILE_X(MLA_STEP_S, tt, pA0, pA1, pB0, pB1)
            MLA_TILE_X(MLA_STEP_S, tt + 1, pB0, pB1, pA0, pA1)
        }
        for (; tt <= nt; tt += 2) {
            MLA_TILE_X(MLA_STEP, tt, pA0, pA1, pB0, pB1)
            if (tt < nt) MLA_TILE_X(MLA_STEP, tt + 1, pB0, pB1, pA0, pA1)
        }
#undef MLA_TILE_X
        l = sum_x32(l);
        att_write_out(cc + (size_t)(b * SEQ + q0 + 32 * wave + r32) * D + h * 64, o0, o1, 1.0f / l, hi);
    }
}
#undef MLA_STEP
#undef MLA_STEP_S
#undef MLA_PHASE_A
#undef MLA_PHASE_B
#undef MLA_FA
#undef MLA_FB
#undef MLA_WFRAG
#undef MLA_ROWMAX
#undef KA
#undef VA

__device__ __forceinline__ bool sb_iter(int it, int nt, int my_first, int qpos, const bf16x8 (&qf)[4], const bf16x8 (&U)[2][4], f32x16& o0, f32x16& o1, float& carry, int& wdone, AttStage<64>& st,
                                        const bf16_t* Kg, const bf16_t* Vg, LAS unsigned char* lds, int tid, int lane, int wave, int r32, int hi) {
            const int t = nt - 1 - it;
            LAS unsigned char* kbuf = lds + ATT_K0 + (it & 1) * AK_BYTES; LAS unsigned char* vbuf = lds + ATT_V0 + (it & 1) * AV_BYTES;
            if (t > 0) att_load<64>(st, Kg + (size_t)(t - 1) * 64 * SBX_PITCH, SBX_PITCH, Vg + (size_t)(t - 1) * 64 * SBX_PITCH, SBX_PITCH, tid);
            if (t <= my_first && !wdone) {
#define SB_FENCE() __builtin_amdgcn_sched_barrier(0)
#define SB_PIN(x) asm volatile("" : "+v"(x))
#define SB_MM(a, b, c) __builtin_amdgcn_mfma_f32_32x32x16_bf16(a, b, c, 0, 0, 0)
#define SB_V1(Z, M, B, TOT) { _Pragma("unroll") for (int q_ = 0; q_ < 4; ++q_) { const float z = Z[(B) + q_], e = fexp2(-fabsf(z)), ls = vmin0f(z) - flog2(1.0f + e); \
                                  Z[(B) + q_] = ls; M[(B) + q_] = ls - z; TOT += M[(B) + q_]; SB_PIN(Z[(B) + q_]); SB_PIN(M[(B) + q_]); } SB_PIN(TOT); }
#define SB_V2(Z, C, B) { _Pragma("unroll") for (int q_ = 0; q_ < 4; ++q_) { Z[(B) + q_] = fexp2(Z[(B) + q_] + (carry + C[(B) + q_])); SB_PIN(Z[(B) + q_]); } }
                const LAS unsigned char* ka = kbuf + r32 * AK_PITCH + hi * 16;
                const LAS unsigned char* va = vbuf + r32 * AV_PITCH + hi * 16;
                const bool diag = t == my_first; const int kb0 = t * 64 + 4 * hi;
                f32x16 z0 = ZERO16, z1, m0, m1; float tot0 = 0.f, tot1 = 0.f;
#pragma unroll
                for (int s = 0; s < 4; ++s) { const bf16x8 a0 = *(const LAS bf16x8*)(ka + 32 * s); z0 = SB_MM(a0, qf[s], z0); }
                if (diag) {
#pragma unroll
                    for (int r = 0; r < 16; ++r) { const int kk = kb0 + (r & 3) + 8 * (r >> 2); z0[r] = (kk < qpos) ? z0[r] : -30000.0f; }
                }
                {   bf16x8 a1 = *(const LAS bf16x8*)(ka + 32 * AK_PITCH), a1n = *(const LAS bf16x8*)(ka + 32 * AK_PITCH + 32);
                    z1 = SB_MM(a1, qf[0], ZERO16); a1 = *(const LAS bf16x8*)(ka + 32 * AK_PITCH + 64); SB_V1(z0, m0, 0, tot0) SB_FENCE();
                    z1 = SB_MM(a1n, qf[1], z1); a1n = *(const LAS bf16x8*)(ka + 32 * AK_PITCH + 96); SB_V1(z0, m0, 4, tot0) SB_FENCE();
                    z1 = SB_MM(a1, qf[2], z1); SB_V1(z0, m0, 8, tot0) SB_FENCE();
                    z1 = SB_MM(a1n, qf[3], z1); SB_V1(z0, m0, 12, tot0) SB_FENCE(); }
                if (diag) {
#pragma unroll
                    for (int r = 0; r < 16; ++r) { const int kk = kb0 + (r & 3) + 8 * (r >> 2); z1[r] = ((kk + 32) < qpos) ? z1[r] : -30000.0f; }
                }
                const bf16x8 lf0 = pack8(m0, 0), lf1 = pack8(m0, 8);
                f32x16 c0, c1;
                c0 = SB_MM(U[0][0], lf0, ZERO16); SB_V1(z1, m1, 0, tot1) SB_FENCE();
                c1 = SB_MM(U[1][0], lf0, ZERO16); SB_V1(z1, m1, 4, tot1) SB_FENCE();
                c0 = SB_MM(U[0][1], lf1, c0); SB_V1(z1, m1, 8, tot1) SB_FENCE();
                c1 = SB_MM(U[1][1], lf1, c1); SB_V1(z1, m1, 12, tot1) SB_FENCE();
                const bf16x8 lf2 = pack8(m1, 0), lf3 = pack8(m1, 8);
                c0 = SB_MM(U[0][2], lf2, c0); c1 = SB_MM(U[1][2], lf2, c1);
                c0 = SB_MM(U[0][3], lf3, c0); c1 = SB_MM(U[1][3], lf3, c1);
                const float tot = sum_x32(tot0 + tot1);
                SB_FENCE();
                SB_V2(z0, c0, 0) SB_V2(z0, c0, 4) SB_V2(z0, c0, 8) SB_V2(z0, c0, 12)
                const bf16x8 wf0 = pack8(z0, 0), wf1 = pack8(z0, 8);
                SB_FENCE();
                {   bf16x8 v0 = *(const LAS bf16x8*)(va), v1 = *(const LAS bf16x8*)(va + 32 * AV_PITCH);
                    o0 = SB_MM(v0, wf0, o0); v0 = *(const LAS bf16x8*)(va + 32); SB_V2(z1, c1, 0) SB_FENCE();
                    o1 = SB_MM(v1, wf0, o1); v1 = *(const LAS bf16x8*)(va + 32 * AV_PITCH + 32); SB_V2(z1, c1, 4) SB_FENCE();
                    o0 = SB_MM(v0, wf1, o0); SB_V2(z1, c1, 8) SB_FENCE();
                    o1 = SB_MM(v1, wf1, o1); SB_V2(z1, c1, 12) SB_FENCE(); }
                const bf16x8 wf2 = pack8(z1, 0), wf3 = pack8(z1, 8);
                { const bf16x8 v0 = *(const LAS bf16x8*)(va + 64), v1 = *(const LAS bf16x8*)(va + 32 * AV_PITCH + 64); o0 = SB_MM(v0, wf2, o0); o1 = SB_MM(v1, wf2, o1); }
                { const bf16x8 v0 = *(const LAS bf16x8*)(va + 96), v1 = *(const LAS bf16x8*)(va + 32 * AV_PITCH + 96); o0 = SB_MM(v0, wf3, o0); o1 = SB_MM(v1, wf3, o1); }
                carry += tot;
#undef SB_FENCE
#undef SB_PIN
#undef SB_MM
#undef SB_V1
#undef SB_V2
            }
            if (t > 0) att_store<64>(st, lds + ATT_K0 + ((it + 1) & 1) * AK_BYTES, lds + ATT_V0 + ((it + 1) & 1) * AV_BYTES, tid);
            LAS int* flg = (LAS int*)(lds + ATT_LDS) + (it & 1) * 8;
            { const int mine = __all((t <= my_first && carry < -151.0f) ? 1 : 0); wdone = mine; if (lane == 0) flg[wave] = mine; }
            __syncthreads();
            int done; { const LAS int* f = flg; done = f[0] & f[1] & f[2] & f[3] & f[4] & f[5] & f[6] & f[7]; }
            return done != 0;
}
__device__ __forceinline__ void phase_sb(KParams p, LAS unsigned char* lds, int bid, int nb, int wid_s) {
    const int tid = opaque_tid(wid_s), lane = tid & 63, wave = __builtin_amdgcn_readfirstlane(tid >> 6), r32 = lane & 31, hi = lane >> 5;
    bf16_t* cc = (bf16_t*)(p->ws + WS_CONCAT);
    bf16x8 U[2][4];
#pragma unroll
    for (int kbo = 0; kbo < 2; ++kbo)
#pragma unroll
        for (int s = 0; s < 4; ++s) {
            bf16x8 f;
#pragma unroll
            for (int j = 0; j < 8; ++j) f[j] = ((16 * s + 8 * (j >> 2) + 4 * hi + (j & 3)) > (32 * kbo + r32)) ? (short)0x3F80 : (short)0;
            U[kbo][s] = f;
        }
    for (int u = bid; u < 512; u += nb) {
        const int slot = (u >> 8) & 1, ub = u & 255, v = (((ub & 7) * 8 + (ub >> 5)) << 2) | ((ub >> 3) & 3), bh = v >> 2, b = bh >> 2, h = bh & 3, sidx = v & 3, qb = slot ? sidx : 7 - sidx;
        const int q0 = qb * 256, nt = 4 * qb + 4, my_first = (q0 + 32 * wave) >> 6, qpos = q0 + 32 * wave + r32;
        const bf16_t* sbx = (const bf16_t*)(p->ws + WS_SBX);
        const bf16_t* Kg = sbx + (size_t)(b * SEQ) * SBX_PITCH + 256 + h * 64; const bf16_t* Vg = sbx + (size_t)(b * SEQ) * SBX_PITCH + 512 + h * 64;
        const bf16_t* qrow = sbx + (size_t)(b * SEQ + qpos) * SBX_PITCH + h * 64 + hi * 8;
        bf16x8 qf[4];
#pragma unroll
        for (int s = 0; s < 4; ++s) { const u32x4 w = *(const u32x4*)(qrow + 16 * s);
            qf[s] = __builtin_bit_cast(bf16x8, (u32x4){pk2(bf_lo(w.x) * SBQ_SCALE, bf_hi(w.x) * SBQ_SCALE), pk2(bf_lo(w.y) * SBQ_SCALE, bf_hi(w.y) * SBQ_SCALE), pk2(bf_lo(w.z) * SBQ_SCALE, bf_hi(w.z) * SBQ_SCALE), pk2(bf_lo(w.w) * SBQ_SCALE, bf_hi(w.w) * SBQ_SCALE)}); }
        f32x16 o0 = ZERO16, o1 = ZERO16; float carry = 0.f; int wdone = 0;
        AttStage<64> stA;
        att_load<64>(stA, Kg + (size_t)(nt - 1) * 64 * SBX_PITCH, SBX_PITCH, Vg + (size_t)(nt - 1) * 64 * SBX_PITCH, SBX_PITCH, tid);
        att_store<64>(stA, lds + ATT_K0, lds + ATT_V0, tid);
        __syncthreads();
        for (int it = 0; it < nt; it += 2) {
            if (sb_iter(it, nt, my_first, qpos, qf, U, o0, o1, carry, wdone, stA, Kg, Vg, lds, tid, lane, wave, r32, hi)) break;
            if (sb_iter(it + 1, nt, my_first, qpos, qf, U, o0, o1, carry, wdone, stA, Kg, Vg, lds, tid, lane, wave, r32, hi)) break;
        }
        __syncthreads();
        att_write_out(cc + (size_t)(b * SEQ + qpos) * D + 768 + h * 64, o0, o1, 1.0f, hi);
    }
}

#define CE(a, b) { const float hi_ = vmaxf(a, b), lo_ = vminf(a, b); a = hi_; b = lo_; }
__device__ __forceinline__ void sort16_desc(float (&x)[16]) { CE(x[0], x[1]) CE(x[2], x[3]) CE(x[0], x[2]) CE(x[1], x[3]) CE(x[1], x[2]) CE(x[4], x[5]) CE(x[6], x[7]) CE(x[4], x[6]) CE(x[5], x[7]) CE(x[5], x[6]) CE(x[0], x[4]) CE(x[2], x[6]) CE(x[2], x[4]) CE(x[1], x[5]) CE(x[3], x[7]) CE(x[3], x[5]) CE(x[1], x[2]) CE(x[3], x[4]) CE(x[5], x[6]) CE(x[8], x[9]) CE(x[10], x[11]) CE(x[8], x[10]) CE(x[9], x[11]) CE(x[9], x[10]) CE(x[12], x[13]) CE(x[14], x[15]) CE(x[12], x[14]) CE(x[13], x[15]) CE(x[13], x[14]) CE(x[8], x[12]) CE(x[10], x[14]) CE(x[10], x[12]) CE(x[9], x[13]) CE(x[11], x[15]) CE(x[11], x[13]) CE(x[9], x[10]) CE(x[11], x[12]) CE(x[13], x[14]) CE(x[0], x[8]) CE(x[4], x[12]) CE(x[4], x[8]) CE(x[2], x[10]) CE(x[6], x[14]) CE(x[6], x[10]) CE(x[2], x[4]) CE(x[6], x[8]) CE(x[10], x[12]) CE(x[1], x[9]) CE(x[5], x[13]) CE(x[5], x[9]) CE(x[3], x[11]) CE(x[7], x[15]) CE(x[7], x[11]) CE(x[3], x[5]) CE(x[7], x[9]) CE(x[11], x[13]) CE(x[1], x[2]) CE(x[3], x[4]) CE(x[5], x[6]) CE(x[7], x[8]) CE(x[9], x[10]) CE(x[11], x[12]) CE(x[13], x[14]) }
__device__ __forceinline__ void bitonic_sort16_desc(float (&M)[16]) {
#pragma unroll
    for (int dlt = 8; dlt >= 1; dlt >>= 1)
#pragma unroll
        for (int i = 0; i < 16; ++i) if ((i & dlt) == 0) CE(M[i], M[i + dlt])
}
__device__ __forceinline__ void merge_top16(float (&R)[16], const float (&S)[16]) {
#pragma unroll
    for (int i = 0; i < 16; ++i) R[i] = vmaxf(R[i], S[15 - i]);
    bitonic_sort16_desc(R);
}
constexpr int TK_KPITCH = 272, TK_KBYTES = 2 * 128 * TK_KPITCH, TK_LV = TK_KBYTES;
__device__ __forceinline__ void phase_topk(KParams p, int l, LAS unsigned char* lds, int bid, int nb, int wid_s) {
    const int tidx = opaque_tid(wid_s);
    const int tid = tidx, lane = tid & 63, wave = tid >> 6, r32 = lane & 31, hi = lane >> 5;
    LAS float* LV = (LAS float*)(lds + TK_LV);
    const bf16_t* PQ = (const bf16_t*)(p->ws + WS_PQ);
    const bf16_t* K1 = (const bf16_t*)(p->ws + WS_K1) + (size_t)l * 8 * 128 * 128; const bf16_t* K2 = (const bf16_t*)(p->ws + WS_K2) + (size_t)l * 8 * 128 * 128;
    int* IDX = (int*)(p->ws + WS_IDX); float* GATE = (float*)(p->ws + WS_GATE);
    int staged_head = -1;
    for (int item = bid; item < (T / 512) * 8; item += nb) {
        const int head = item & 7, tt = item >> 3;
        if (head != staged_head) {
            __syncthreads();
            for (int ch = tid; ch < 2 * 128 * 16; ch += NTHR) { const int half = ch >> 11, row = (ch >> 4) & 127, c16 = ch & 15;
                const u32x4 v = *(const u32x4*)((half ? K2 : K1) + ((size_t)head * 128 + row) * 128 + c16 * 8);
                *(LAS u32x4*)(lds + (half * 128 + row) * TK_KPITCH + c16 * 16) = v; }
            staged_head = head;
            __syncthreads();
        }
        bf16x8 qn[8];
        {   const int half = wave & 1, st = wave >> 1; const bf16_t* qrow = PQ + ((((size_t)head * (T / 32) + (tt * 16 + st)) * 2 + half) * 8) * 512 + lane * 8;
#pragma unroll
            for (int s = 0; s < 8; ++s) qn[s] = *(const bf16x8*)(qrow + 512 * s); }
        for (int task = wave; task < 32; task += 8) {
            const int half = task & 1, st = task >> 1;
            bf16x8 qf[8];
#pragma unroll
            for (int s = 0; s < 8; ++s) qf[s] = qn[s];
            if (task + 8 < 32) { const int t2 = task + 8, half2 = t2 & 1, st2 = t2 >> 1; const bf16_t* qrow = PQ + ((((size_t)head * (T / 32) + (tt * 16 + st2)) * 2 + half2) * 8) * 512 + lane * 8;
#pragma unroll
                for (int s = 0; s < 8; ++s) qn[s] = *(const bf16x8*)(qrow + 512 * s); }
            const LAS unsigned char* kbase = lds + (half * 128 + r32) * TK_KPITCH + hi * 16;
            float Lst[16];
#pragma unroll
            for (int kb = 0; kb < 4; ++kb) {
                f32x16 acc = {0.f, 0.f, 0.f, 0.f, 0.f, 0.f, 0.f, 0.f, 0.f, 0.f, 0.f, 0.f, 0.f, 0.f, 0.f, 0.f};
#pragma unroll
                for (int s = 0; s < 8; ++s) { const bf16x8 kf = *(const LAS bf16x8*)(kbase + kb * 32 * TK_KPITCH + 32 * s); acc = __builtin_amdgcn_mfma_f32_32x32x16_bf16(kf, qf[s], acc, 0, 0, 0); }
                float x[16];
#pragma unroll
                for (int r = 0; r < 16; ++r) {
                    const int key = kb * 32 + (r & 3) + 8 * (r >> 2) + 4 * hi;
                    const float av = acc[r];
                    x[r] = __uint_as_float((__float_as_uint(av) & 0xffffff80u) | (unsigned)key);
                }
                sort16_desc(x);
                if (kb == 0) {
#pragma unroll
                    for (int r = 0; r < 16; ++r) Lst[r] = x[r];
                } else merge_top16(Lst, x);
            }
            float M[16];
#pragma unroll
            for (int i = 0; i < 16; ++i) { float a = Lst[15 - i], b = Lst[i]; swap32(a, b); M[i] = vmaxf(Lst[i], b); }
            bitonic_sort16_desc(M);
            if (hi == 0) {
                LAS float* dst = LV + ((size_t)(half * 512 + st * 32 + r32)) * 16;
#pragma unroll
                for (int i = 0; i < 16; i += 4) *(LAS f32x4*)(dst + i) = (f32x4){M[i], M[i + 1], M[i + 2], M[i + 3]};
            }
        }
        __syncthreads();
        {
            const int tok = tid, t = tt * 512 + tok;
            const LAS float* a1 = LV + (size_t)tok * 16; const LAS float* a2 = LV + (size_t)(512 + tok) * 16;
            float v1[16], v2[16];
#pragma unroll
            for (int i = 0; i < 16; i += 4) { const f32x4 x = *(const LAS f32x4*)(a1 + i), y = *(const LAS f32x4*)(a2 + i); v1[i] = x.x; v1[i + 1] = x.y; v1[i + 2] = x.z; v1[i + 3] = x.w; v2[i] = y.x; v2[i + 1] = y.y; v2[i + 2] = y.z; v2[i + 3] = y.w; }
            float Tt[16]; { OPQF(NEG, -3.0e38f);
#pragma unroll
            for (int i = 0; i < 16; ++i) Tt[i] = NEG; }
#pragma unroll
            for (int i = 0; i < 16; ++i)
#pragma unroll
                for (int j = 0; j < 16; ++j) if ((i + 1) * (j + 1) <= 16) {
                    const float sum = v1[i] + v2[j];
                    float xx = __builtin_bit_cast(float, (__builtin_bit_cast(unsigned, sum) & 0xffffff00u) | (unsigned)(i * 16 + j));
#pragma unroll
                    for (int lv = (i + 1) * (j + 1) - 1; lv < 16; ++lv) { const float hi_ = vmaxf(Tt[lv], xx); xx = vminf(Tt[lv], xx); Tt[lv] = hi_; }
                }
            float e[16], den = 0.f;
#pragma unroll
            for (int k = 0; k < 16; ++k) { e[k] = __expf(Tt[k] - Tt[0]); den += e[k]; }
            const float inv = 1.0f / den;
            int ex[16];
#pragma unroll
            for (int k = 0; k < 16; ++k) {
                const unsigned pos = __builtin_bit_cast(unsigned, Tt[k]) & 0xffu;
                const unsigned i1 = __builtin_bit_cast(unsigned, a1[pos >> 4]) & 0x7fu, i2 = __builtin_bit_cast(unsigned, a2[pos & 15]) & 0x7fu;
                ex[k] = (int)(i1 * 128u + i2);
            }
            int* ip = IDX + (size_t)t * 128 + head * 16; float* gp = GATE + (size_t)t * 128 + head * 16;
#pragma unroll
            for (int k = 0; k < 16; k += 4) { *(u32x4*)(ip + k) = (u32x4){(unsigned)ex[k], (unsigned)ex[k + 1], (unsigned)ex[k + 2], (unsigned)ex[k + 3]}; *(f32x4*)(gp + k) = (f32x4){e[k] * inv, e[k + 1] * inv, e[k + 2] * inv, e[k + 3] * inv}; }
        }
        __syncthreads();
    }
}

__device__ __forceinline__ void rowc_load_f32(const float* row, int lane, float (&v)[16]) {
    const f32x4 a = *(const f32x4*)(row + 16 * lane), b = *(const f32x4*)(row + 16 * lane + 4), c = *(const f32x4*)(row + 16 * lane + 8), d = *(const f32x4*)(row + 16 * lane + 12);
    v[0] = a.x; v[1] = a.y; v[2] = a.z; v[3] = a.w; v[4] = b.x; v[5] = b.y; v[6] = b.z; v[7] = b.w;
    v[8] = c.x; v[9] = c.y; v[10] = c.z; v[11] = c.w; v[12] = d.x; v[13] = d.y; v[14] = d.z; v[15] = d.w;
}
__device__ __forceinline__ void rowc_load_bf16(const bf16_t* row, int lane, float (&v)[16]) {
    const u32x4 a = *(const u32x4*)(row + 16 * lane), b = *(const u32x4*)(row + 16 * lane + 8);
    v[0] = bf_lo(a.x); v[1] = bf_hi(a.x); v[2] = bf_lo(a.y); v[3] = bf_hi(a.y); v[4] = bf_lo(a.z); v[5] = bf_hi(a.z); v[6] = bf_lo(a.w); v[7] = bf_hi(a.w);
    v[8] = bf_lo(b.x); v[9] = bf_hi(b.x); v[10] = bf_lo(b.y); v[11] = bf_hi(b.y); v[12] = bf_lo(b.z); v[13] = bf_hi(b.z); v[14] = bf_lo(b.w); v[15] = bf_hi(b.w);
}
__device__ __forceinline__ void rowc_store_f32(float* row, int lane, const float (&v)[16]) {
    *(f32x4*)(row + 16 * lane) = (f32x4){v[0], v[1], v[2], v[3]}; *(f32x4*)(row + 16 * lane + 4) = (f32x4){v[4], v[5], v[6], v[7]};
    *(f32x4*)(row + 16 * lane + 8) = (f32x4){v[8], v[9], v[10], v[11]}; *(f32x4*)(row + 16 * lane + 12) = (f32x4){v[12], v[13], v[14], v[15]};
}
__device__ __forceinline__ void rowc_store_bf16(bf16_t* row, int lane, const float (&v)[16]) {
    *(u32x4*)(row + 16 * lane) = (u32x4){pk2(v[0], v[1]), pk2(v[2], v[3]), pk2(v[4], v[5]), pk2(v[6], v[7])};
    *(u32x4*)(row + 16 * lane + 8) = (u32x4){pk2(v[8], v[9]), pk2(v[10], v[11]), pk2(v[12], v[13]), pk2(v[14], v[15])};
}
__device__ __forceinline__ void vdot_group(int (&Lo)[16], int (&By)[16], u32x4 w0, u32x4 w1, u32x4 w2, u32x4 w3, unsigned C) {
#define VD(d, X) { const unsigned p01l = __builtin_amdgcn_perm(w1.X, w0.X, 0x05010400u), p01h = __builtin_amdgcn_perm(w1.X, w0.X, 0x07030602u); \
                   const unsigned p23l = __builtin_amdgcn_perm(w3.X, w2.X, 0x05010400u), p23h = __builtin_amdgcn_perm(w3.X, w2.X, 0x07030602u); \
                   const unsigned t0 = __builtin_amdgcn_perm(p23l, p01l, 0x05040100u), t1 = __builtin_amdgcn_perm(p23l, p01l, 0x07060302u); \
                   const unsigned t2 = __builtin_amdgcn_perm(p23h, p01h, 0x05040100u), t3 = __builtin_amdgcn_perm(p23h, p01h, 0x07060302u); \
                   Lo[4 * d] = __builtin_amdgcn_sdot4((int)(t0 & 0x0F0F0F0Fu), (int)C, Lo[4 * d], false); By[4 * d] = __builtin_amdgcn_sdot4((int)t0, (int)C, By[4 * d], false); \
                   Lo[4 * d + 1] = __builtin_amdgcn_sdot4((int)(t1 & 0x0F0F0F0Fu), (int)C, Lo[4 * d + 1], false); By[4 * d + 1] = __builtin_amdgcn_sdot4((int)t1, (int)C, By[4 * d + 1], false); \
                   Lo[4 * d + 2] = __builtin_amdgcn_sdot4((int)(t2 & 0x0F0F0F0Fu), (int)C, Lo[4 * d + 2], false); By[4 * d + 2] = __builtin_amdgcn_sdot4((int)t2, (int)C, By[4 * d + 2], false); \
                   Lo[4 * d + 3] = __builtin_amdgcn_sdot4((int)(t3 & 0x0F0F0F0Fu), (int)C, Lo[4 * d + 3], false); By[4 * d + 3] = __builtin_amdgcn_sdot4((int)t3, (int)C, By[4 * d + 3], false); }
    VD(0, x) VD(1, y) VD(2, z) VD(3, w)
#undef VD
}
__device__ __forceinline__ void swap32i(int& a, int& b) { const auto r = __builtin_amdgcn_permlane32_swap((unsigned)a, (unsigned)b, false, false); a = (int)r[0]; b = (int)r[1]; }
__device__ __forceinline__ void swap16i(int& a, int& b) { const auto r = __builtin_amdgcn_permlane16_swap((unsigned)a, (unsigned)b, false, false); a = (int)r[0]; b = (int)r[1]; }
__device__ __forceinline__ int dot32_i4(u32x4 w, u32x4 A, u32x4 B) {
    int a = __builtin_amdgcn_sdot8((int)w.x, (int)A.x, 0, false); a = __builtin_amdgcn_sdot8((int)w.y, (int)A.y, a, false); a = __builtin_amdgcn_sdot8((int)w.z, (int)A.z, a, false); a = __builtin_amdgcn_sdot8((int)w.w, (int)A.w, a, false);
    int b = __builtin_amdgcn_sdot8((int)w.x, (int)B.x, 0, false); b = __builtin_amdgcn_sdot8((int)w.y, (int)B.y, b, false); b = __builtin_amdgcn_sdot8((int)w.z, (int)B.z, b, false); b = __builtin_amdgcn_sdot8((int)w.w, (int)B.w, b, false);
    return a * 16 + b;
}
__device__ __forceinline__ void phase_experts(KParams p, int l, bool last, LAS unsigned char* lds, int bid, int nb, int wid_s) {
    const int tidx = opaque_tid(wid_s);
    const int lane = tidx & 63, wave = __builtin_amdgcn_readfirstlane(tidx >> 6), j = lane >> 3, c = lane & 7, gw = bid * 8 + wave, ngw = nb * 8;
    const unsigned char* H2Q = p->ws + WS_H2Q; const float* HQS = (const float*)(p->ws + WS_HQS);
    const unsigned char* UB = p->ws + WS_UB + (size_t)l * TAB4_LAYER; const unsigned char* VB = p->ws + WS_VB + (size_t)l * TAB4_LAYER;
    const int* IDX = (const int*)(p->ws + WS_IDX); const float* GATE = (const float*)(p->ws + WS_GATE);
    const float* mod = (const float*)(p->ws + WS_MOD);
    bf16_t* OUTF = (bf16_t*)(p->ws + WS_PQ);
    const bf16_t* X1 = x1_buffer(p, l); float* XO = p->out; bf16_t* X2B = (bf16_t*)(p->ws + WS_X2); bf16_t* H1 = (bf16_t*)(p->ws + WS_H1);
    LAS float* cf = (LAS float*)(lds + wave * 16384);
    LAS int* ix = (LAS int*)(lds + wave * 16384 + 8192);
    for (int tb = 16 * gw; tb < T; tb += 16 * ngw) {
        for (int i = 0; i < 16; ++i) { int t = tb + i; t = t < T ? t : T - 1;
            const int k0 = lane, k1 = lane + 64;
            ix[i * 128 + (k0 & 7) * 16 + (k0 >> 3)] = IDX[(size_t)t * 128 + k0]; ix[i * 128 + (k1 & 7) * 16 + (k1 >> 3)] = IDX[(size_t)t * 128 + k1]; }
        asm volatile("s_waitcnt vmcnt(0) lgkmcnt(0)" ::: "memory");
        const unsigned offc = 16u * (unsigned)c;
#define ALOAD(dst, voff, sbase) asm volatile("global_load_dwordx4 %0, %1, %2" : "=v"(dst) : "v"(voff), "s"(sbase) : "memory")
#define ALOADO(dst, voff, sbase, O) asm volatile("global_load_dwordx4 %0, %1, %2 offset:" #O : "=v"(dst) : "v"(voff), "s"(sbase) : "memory")
#define ALOADT(dst, voff, sbase) asm volatile("global_load_dwordx4 %0, %1, %2" : "+v"(dst) : "v"(voff), "s"(sbase) : "memory")
#define ALOADOT(dst, voff, sbase, O) asm volatile("global_load_dwordx4 %0, %1, %2 offset:" #O : "+v"(dst) : "v"(voff), "s"(sbase) : "memory")
#define AWAIT8(N, W) asm volatile("s_waitcnt vmcnt(" #N ")" : "+v"(W[0]), "+v"(W[1]), "+v"(W[2]), "+v"(W[3]), "+v"(W[4]), "+v"(W[5]), "+v"(W[6]), "+v"(W[7]) :: "memory")
#define ISSUE8(W, base, ea, eb) { ALOAD(W[0], (ea).x * 128u + offc, base); ALOAD(W[1], (ea).y * 128u + offc, base); ALOAD(W[2], (ea).z * 128u + offc, base); ALOAD(W[3], (ea).w * 128u + offc, base); \
                                    ALOAD(W[4], (eb).x * 128u + offc, base); ALOAD(W[5], (eb).y * 128u + offc, base); ALOAD(W[6], (eb).z * 128u + offc, base); ALOAD(W[7], (eb).w * 128u + offc, base); }
        {
            u32x4 wa[8], wb[8], hA, hB;
            const unsigned hoff = 32u * (unsigned)c;
            {   int t0 = tb < T ? tb : T - 1; const unsigned char* hb = H2Q + (size_t)t0 * 1024; const unsigned char* Ub0 = UB;
                const LAS u32x4* ie = (const LAS u32x4*)(ix + j * 16); const u32x4 e0 = ie[0], e1 = ie[1], e2 = ie[2], e3 = ie[3];
                ALOAD(hA, hoff, hb); ALOADO(hB, hoff, hb, 16); ISSUE8(wa, Ub0, e0, e1) ISSUE8(wb, Ub0, e2, e3) }
#pragma unroll 1
            for (int r = 0; r < 64; ++r) {
                const int cb = r >> 4, i = r & 15, t = tb + i;
                const int r2 = r < 63 ? r + 1 : 63, cb2 = r2 >> 4, i2 = r2 & 15; int t2 = tb + i2; t2 = t2 < T ? t2 : T - 1;
                const unsigned char* Ub2 = UB + (size_t)cb2 * NEXP * 128; const unsigned char* hb2 = H2Q + (size_t)t2 * 1024 + 256 * cb2;
                const LAS u32x4* ie2 = (const LAS u32x4*)(ix + i2 * 128 + j * 16); const u32x4 f0 = ie2[0], f1 = ie2[1], f2 = ie2[2], f3 = ie2[3];
                asm volatile("s_waitcnt vmcnt(8)" : "+v"(hA), "+v"(hB), "+v"(wa[0]), "+v"(wa[1]), "+v"(wa[2]), "+v"(wa[3]), "+v"(wa[4]), "+v"(wa[5]), "+v"(wa[6]), "+v"(wa[7]) :: "memory");
                u32x4 cA = hA, cB = hB; asm volatile("" : "+v"(cA), "+v"(cB));
                int pd[16];
#pragma unroll
                for (int m = 0; m < 8; ++m) pd[m] = dot32_i4(wa[m], cA, cB);
                asm volatile("" : "+v"(pd[0]), "+v"(pd[1]), "+v"(pd[2]), "+v"(pd[3]), "+v"(pd[4]), "+v"(pd[5]), "+v"(pd[6]), "+v"(pd[7]) :: "memory");
                ALOADT(hA, hoff, hb2); ALOADOT(hB, hoff, hb2, 16); ISSUE8(wa, Ub2, f0, f1)
                AWAIT8(10, wb);
#pragma unroll
                for (int m = 0; m < 8; ++m) pd[8 + m] = dot32_i4(wb[m], cA, cB);
                asm volatile("" : "+v"(pd[8]), "+v"(pd[9]), "+v"(pd[10]), "+v"(pd[11]), "+v"(pd[12]), "+v"(pd[13]), "+v"(pd[14]), "+v"(pd[15]) :: "memory");
                ISSUE8(wb, Ub2, f2, f3)
#pragma unroll
                for (int m = 0; m < 8; ++m) { const bool up = (c & 4) != 0; const int keep = up ? pd[m + 8] : pd[m], give = up ? pd[m] : pd[m + 8]; pd[m] = keep + sxori<4>(give); }
#pragma unroll
                for (int m = 0; m < 4; ++m) { const bool up = (c & 2) != 0; const int keep = up ? pd[m + 4] : pd[m], give = up ? pd[m] : pd[m + 4]; pd[m] = keep + sxori<2>(give); }
#pragma unroll
                for (int m = 0; m < 2; ++m) { const bool up = (c & 1) != 0; const int keep = up ? pd[m + 2] : pd[m], give = up ? pd[m] : pd[m + 2]; pd[m] = keep + sxori<1>(give); }
                LAS i32x2_t* ap = (LAS i32x2_t*)(cf + i * 128 + j * 16 + 2 * c);
                i32x2_t a = (i32x2_t){pd[0], pd[1]};
                if (cb > 0) a += *ap;
                if (cb == 3 && t < T) {
                    const int k0 = 16 * c + j;
                    const f32x2_t hq = *(const f32x2_t*)(HQS + 2 * (size_t)t);
                    const float ox = GATE[(size_t)t * 128 + k0] * gelu_exact(((float)a.x + hq.y) * hq.x), oy = GATE[(size_t)t * 128 + k0 + 8] * gelu_exact(((float)a.y + hq.y) * hq.x);
                    const float cmax = fmaxf(wave_max(fmaxf(fabsf(ox), fabsf(oy))), 1.0e-30f), qs = 127.0f / cmax;
                    const int cx = (int)__builtin_rintf(ox * qs), cy = (int)__builtin_rintf(oy * qs);
                    const float csum = wave_sum((float)(cx + cy));
                    LAS unsigned char* tokb = (LAS unsigned char*)(cf + i * 128);
                    *(LAS unsigned short*)(tokb + j * 16 + 2 * c) = (unsigned short)((cx & 255) | ((cy & 255) << 8));
                    if (lane == 0) *(LAS f32x2_t*)(tokb + 128) = (f32x2_t){cmax * (V_STEP / 127.0f), csum};
                } else *ap = a;
            }
            asm volatile("s_waitcnt vmcnt(0)" : "+v"(hA), "+v"(hB), "+v"(wa[0]), "+v"(wa[1]), "+v"(wa[2]), "+v"(wa[3]), "+v"(wa[4]), "+v"(wa[5]), "+v"(wa[6]), "+v"(wa[7]) :: "memory");
            AWAIT8(0, wb);
        }
        {
            u32x4 wa[8], wb[8];
            {   const LAS u32x4* ie = (const LAS u32x4*)(ix + j * 16); const u32x4 e0 = ie[0], e1 = ie[1], e2 = ie[2], e3 = ie[3]; const unsigned char* Vb0 = VB;
                ISSUE8(wa, Vb0, e0, e1) ISSUE8(wb, Vb0, e2, e3) }
#pragma unroll 1
            for (int r = 0; r < 64; ++r) {
                const int cb = r >> 4, i = r & 15, t = tb + i;
                const int r2 = r < 63 ? r + 1 : 63, cb2 = r2 >> 4, i2 = r2 & 15;
                const unsigned char* Vb2 = VB + (size_t)cb2 * NEXP * 128;
                const LAS u32x4* ie2 = (const LAS u32x4*)(ix + i2 * 128 + j * 16); const u32x4 f0 = ie2[0], f1 = ie2[1], f2 = ie2[2], f3 = ie2[3];
                const LAS unsigned char* tokb = (const LAS unsigned char*)(cf + i * 128);
                const u32x4 c8 = *(const LAS u32x4*)(tokb + j * 16); const f32x2_t sq = *(const LAS f32x2_t*)(tokb + 128);
                AWAIT8(8, wa);
                int Lo[16], By[16];
#pragma unroll
                for (int q = 0; q < 16; ++q) { Lo[q] = 0; By[q] = 0; }
                vdot_group(Lo, By, wa[0], wa[1], wa[2], wa[3], c8.x); __builtin_amdgcn_sched_barrier(0);
                vdot_group(Lo, By, wa[4], wa[5], wa[6], wa[7], c8.y); __builtin_amdgcn_sched_barrier(0);
                asm volatile("" : "+v"(Lo[0]), "+v"(Lo[4]), "+v"(Lo[8]), "+v"(Lo[12]), "+v"(By[0]), "+v"(By[4]), "+v"(By[8]), "+v"(By[12]), "+v"(By[15]) :: "memory");
                ISSUE8(wa, Vb2, f0, f1)
                AWAIT8(8, wb);
                vdot_group(Lo, By, wb[0], wb[1], wb[2], wb[3], c8.z); __builtin_amdgcn_sched_barrier(0);
                vdot_group(Lo, By, wb[4], wb[5], wb[6], wb[7], c8.w); __builtin_amdgcn_sched_barrier(0);
                asm volatile("" : "+v"(Lo[0]), "+v"(Lo[4]), "+v"(Lo[8]), "+v"(Lo[12]), "+v"(By[0]), "+v"(By[4]), "+v"(By[8]), "+v"(By[12]), "+v"(By[15]) :: "memory");
                ISSUE8(wb, Vb2, f2, f3)
                int acc[32];
#pragma unroll
                for (int q = 0; q < 16; ++q) { acc[2 * q] = Lo[q]; acc[2 * q + 1] = By[q]; }
#pragma unroll
                for (int m = 0; m < 16; ++m) { int a = acc[m], b = acc[m + 16]; swap32i(a, b); acc[m] = a + b; }
#pragma unroll
                for (int m = 0; m < 8; ++m) { int a = acc[m], b = acc[m + 8]; swap16i(a, b); acc[m] = a + b; }
#pragma unroll
                for (int m = 0; m < 4; ++m) { const bool up = (j & 1) != 0; const int keep = up ? acc[m + 4] : acc[m], give = up ? acc[m] : acc[m + 4]; acc[m] = keep + sxori<8>(give); }
                const float o0 = sq.x * ((float)acc[0] - 7.5f * sq.y), o1 = sq.x * ((float)((acc[1] - acc[0]) >> 4) + 0.5f * sq.y);
                const float o2 = sq.x * ((float)acc[2] - 7.5f * sq.y), o3 = sq.x * ((float)((acc[3] - acc[2]) >> 4) + 0.5f * sq.y);
                if (t < T) *(u32x2*)(OUTF + (size_t)t * D + 256 * cb + 32 * c + 4 * j) = (u32x2){pk2(o0, o1), pk2(o2, o3)};
            }
            AWAIT8(0, wa); AWAIT8(0, wb);
        }
#undef ALOAD
#undef ALOADO
#undef ALOADT
#undef ALOADOT
#undef AWAIT8
#undef ISSUE8
        int ln = lane; asm volatile("" : "+v"(ln));
        if (tb < T) {
            const int bidx = tb / SEQ;
            const float* m = mod + ((size_t)l * 16 + bidx) * 6144;
            float g2[16], gg[16], bb[16], sh[16], sc[16];
            rowc_load_f32(m + 5120, ln, g2); rowc_load_f32(p->ln2_g + l * D, ln, gg); rowc_load_f32(p->ln2_b + l * D, ln, bb);
            if (!last) { const float* mn = mod + ((size_t)(l + 1) * 16 + bidx) * 6144; rowc_load_f32(mn, ln, sh); rowc_load_f32(mn + 1024, ln, sc); }
            u32x4 nx0 = *(const u32x4*)(X1 + (size_t)tb * D + 16 * ln), nx1 = *(const u32x4*)(X1 + (size_t)tb * D + 16 * ln + 8);
            u32x4 no0 = *(const u32x4*)(OUTF + (size_t)tb * D + 16 * ln), no1 = *(const u32x4*)(OUTF + (size_t)tb * D + 16 * ln + 8);
#pragma unroll 1
            for (int i = 0; i < 16; ++i) { const int t = tb + i; if (t >= T) break;
                const u32x4 x0 = nx0, x1 = nx1, o0 = no0, o1 = no1;
                if (i + 1 < 16 && t + 1 < T) { const size_t tn = (size_t)(t + 1) * D + 16 * ln;
                    nx0 = *(const u32x4*)(X1 + tn); nx1 = *(const u32x4*)(X1 + tn + 8); no0 = *(const u32x4*)(OUTF + tn); no1 = *(const u32x4*)(OUTF + tn + 8); }
                float xv[16];
                { const unsigned xw[8] = {x0.x, x0.y, x0.z, x0.w, x1.x, x1.y, x1.z, x1.w}, ow[8] = {o0.x, o0.y, o0.z, o0.w, o1.x, o1.y, o1.z, o1.w};
#pragma unroll
                  for (int q = 0; q < 8; ++q) { xv[2 * q] = ALPHA * bf_lo(xw[q]) + (1.0f + g2[2 * q]) * bf_lo(ow[q]); xv[2 * q + 1] = ALPHA * bf_hi(xw[q]) + (1.0f + g2[2 * q + 1]) * bf_hi(ow[q]); } }
                row_normalize(xv);
#pragma unroll
                for (int q = 0; q < 16; ++q) xv[q] = xv[q] * gg[q] + bb[q];
                if (last) rowc_store_f32(XO + (size_t)t * D, ln, xv);
                if (!last) {
                    rowc_store_bf16(X2B + (size_t)t * D, ln, xv);
                    row_normalize(xv);
#pragma unroll
                    for (int q = 0; q < 16; ++q) xv[q] = xv[q] * (1.0f + sc[q]) + sh[q];
                    rowc_store_bf16(H1 + (size_t)t * D, ln, xv);
                }
            }
        }
    }
}

#define XB_TMO      128
#define XB_XCNT(j)  (256  + 64 * (j))
#define XB_XSUB(j)  (1280 + 64 * (j))
#define XB_XGEN(j)  (2304 + 64 * (j))
#define XB_TOP      3328
#define XB_TOPGEN   3392
#define XCD_BAR_WORDS 3456
#define XB_SPIN_CAP (1u << 18)

__device__ __forceinline__ unsigned xb_ld(unsigned* p)              { return __hip_atomic_load(p, __ATOMIC_RELAXED, __HIP_MEMORY_SCOPE_AGENT); }
__device__ __forceinline__ unsigned xb_add(unsigned* p, unsigned v) { return __hip_atomic_fetch_add(p, v, __ATOMIC_RELAXED, __HIP_MEMORY_SCOPE_AGENT); }
__device__ __forceinline__ unsigned xb_xcc_id() { return (unsigned)__builtin_amdgcn_s_getreg((3 << 11) | 20) & 0xFu; }
#define XB_SPIN(cond, bar) do { unsigned _sp = 0; while (cond) { __builtin_amdgcn_s_sleep(1); \
    if ((++_sp & 255u) == 0u) { if (xb_ld(&(bar)[XB_TMO])) break; if (_sp > XB_SPIN_CAP) { atomicAdd(&(bar)[XB_TMO], 1u); break; } } } } while (0)

struct XcdBarrier {
    unsigned* bar; unsigned x;
    volatile LAS unsigned* st;
};

__device__ __forceinline__ XcdBarrier xcd_barrier_post(unsigned* bar, volatile LAS unsigned* st, bool leader) {
    XcdBarrier b; b.bar = bar; b.x = xb_xcc_id(); b.st = st;
    if (leader) (void)xb_add(&bar[XB_XCNT(b.x)], 1u);
    return b;
}
__device__ __forceinline__ void xcd_barrier_complete(unsigned* bar, unsigned x, unsigned& nloc, unsigned& nx) {
    const unsigned G = gridDim.x * gridDim.y * gridDim.z;
    unsigned sum, cnt, mine, sp = 0u;
    for (;;) {
        sum = 0u; cnt = 0u; mine = 0u;
#pragma unroll
        for (unsigned j = 0; j < 16; ++j) { const unsigned c = xb_ld(&bar[XB_XCNT(j)]); sum += c; cnt += (c > 0u) ? 1u : 0u; mine = (j == x) ? c : mine; }
        if (sum == G) break;
        __builtin_amdgcn_s_sleep(1);
        if ((++sp & 255u) == 0u) { if (xb_ld(&bar[XB_TMO])) break; if (sp > XB_SPIN_CAP) { atomicAdd(&bar[XB_TMO], 1u); break; } }
    }
    nloc = mine > 0u ? mine : 1u; nx = cnt > 0u ? cnt : 1u;
}

__device__ __forceinline__ void xcd_barrier(const XcdBarrier& b, bool leader) {
    asm volatile("s_waitcnt vmcnt(0)" ::: "memory");
    __syncthreads();
    if (leader) {
        unsigned* bar = b.bar; asm volatile("" : "+s"(bar));
        __builtin_amdgcn_s_waitcnt(0);
        unsigned nloc = b.st[0], nx = b.st[1];
        if (nloc == 0u) { xcd_barrier_complete(bar, b.x, nloc, nx); b.st[0] = nloc; b.st[1] = nx; }
        const unsigned old = xb_add(&bar[XB_XSUB(b.x)], 1u);
        const unsigned gen = old / nloc;
        if (old + 1u == (gen + 1u) * nloc) {
            __builtin_amdgcn_fence(__ATOMIC_RELEASE, "agent");
            asm volatile("s_waitcnt vmcnt(0)" ::: "memory");
            const unsigned og = xb_add(&bar[XB_TOP], 1u);
            const unsigned tg = og / nx;
            if (og + 1u == (tg + 1u) * nx) xb_add(&bar[XB_TOPGEN], 1u);
            else XB_SPIN(xb_ld(&bar[XB_TOPGEN]) == tg, bar);
            __builtin_amdgcn_fence(__ATOMIC_ACQUIRE, "agent");
            xb_add(&bar[XB_XGEN(b.x)], 1u);
            asm volatile("s_waitcnt vmcnt(0)" ::: "memory");
        } else {
            XB_SPIN(xb_ld(&bar[XB_XGEN(b.x)]) == gen, bar);
            __builtin_amdgcn_fence(__ATOMIC_ACQUIRE, "agent");
            asm volatile("s_waitcnt vmcnt(0)" ::: "memory");
        }
    }
    __syncthreads();
}
namespace cg = cooperative_groups;
extern __shared__ __attribute__((aligned(16))) unsigned char dyn_lds[];
__global__ void __launch_bounds__(NTHR, 2) mega(Params kernel_args) {
    (void)kernel_args;
    KParams p = (KParams)__builtin_amdgcn_kernarg_segment_ptr();
    cg::grid_group grid = cg::this_grid();
    LAS unsigned char* lds = (LAS unsigned char*)dyn_lds;
    int bid = blockIdx.x, nb = gridDim.x; const int wid_s = __builtin_amdgcn_readfirstlane(threadIdx.x >> 6);
    unsigned char* ws = p->ws;
    volatile LAS unsigned* bar_st = (volatile LAS unsigned*)(lds + LDS_BYTES - 64);
    const bool leader = (opaque_tid(wid_s) == 0);
    if (leader) { bar_st[0] = 0u; bar_st[1] = 0u; }
    if (bid == 0) {
        unsigned* bw = (unsigned*)(ws + WS_CTL + 16384);
        for (int i = opaque_tid(wid_s); i < XCD_BAR_WORDS; i += NTHR) __hip_atomic_store(bw + i, 0u, __ATOMIC_RELAXED, __HIP_MEMORY_SCOPE_AGENT);
        asm volatile("s_waitcnt vmcnt(0)" ::: "memory");
    }
    __syncthreads();
#define GRID_BAR() { XcdBarrier xb_; xb_.bar = (unsigned*)(ws + WS_CTL + 16384); xb_.x = xb_xcc_id(); xb_.st = (volatile LAS unsigned*)(lds + LDS_BYTES - 64); xcd_barrier(xb_, opaque_tid(wid_s) == 0); }
#define OPQ_SEEDS() asm volatile("" : "+s"(ws), "+s"(p), "+s"(bid), "+s"(nb))
    OPQ_SEEDS();
    phase_prep_weights(p, lds, bid, nb, wid_s);
    __syncthreads();
    phase_mod(p, lds, bid, nb, wid_s);
    phase_prep_tables(p, bid, nb, wid_s);
    grid.sync();
    (void)xcd_barrier_post((unsigned*)(ws + WS_CTL + 16384), bar_st, leader);
    OPQ_SEEDS();
    phase_rowA(p, 0, p->x, bid, nb, wid_s);
    GRID_BAR();
#pragma unroll
    for (int l = 0; l < NL; ++l) {
        OPQ_SEEDS();
        {
            EpiProj e{p};
            gemm_fast(lds, (const bf16_t*)(ws + WS_H1), (const bf16_t*)(ws + WS_WIN) + (size_t)l * NPROJ * D, T, NPROJ, D, e, bid, nb, wid_s);
        }
        GRID_BAR(); OPQ_SEEDS();
        {
            EpiQ eq{p};
            gemm_fast(lds, (const bf16_t*)(ws + WS_QLAT), (const bf16_t*)(ws + WS_WUQ) + (size_t)l * 768 * 256, T, 768, 256, eq, bid, nb, wid_s);
            EpiKV ek{p};
            gemm_fast(lds, (const bf16_t*)(ws + WS_KVLAT), (const bf16_t*)(ws + WS_WUKV) + (size_t)l * 1024 * 128, T, 1024, 128, ek, bid, nb, wid_s);
            phase_conv_krope(p, l, bid, nb, wid_s);
        }
        GRID_BAR(); OPQ_SEEDS();
        phase_mla(p, lds, bid, nb, wid_s);
        phase_sb(p, lds, bid, nb, wid_s);
        GRID_BAR(); OPQ_SEEDS();
        {
            EpiY e{p, l};
            gemm_fast(lds, (const bf16_t*)(ws + WS_CONCAT), (const bf16_t*)(ws + WS_WO) + (size_t)l * D * D, T, D, D, e, bid, nb, wid_s);
        }
        GRID_BAR(); OPQ_SEEDS();
        phase_rowF(p, l, bid, nb, wid_s);
        GRID_BAR(); OPQ_SEEDS();
        {
            EpiBf e{p};
            gemm_fast(lds, (const bf16_t*)(ws + WS_H2), (const bf16_t*)(ws + WS_WQ) + (size_t)l * 2048 * D, T, 2048, D, e, bid, nb, wid_s);
        }
        GRID_BAR(); OPQ_SEEDS();
        phase_topk(p, l, lds, bid, nb, wid_s);
        GRID_BAR(); OPQ_SEEDS();
        phase_experts(p, l, l == NL - 1, lds, bid, nb, wid_s);
        if (l + 1 < NL) GRID_BAR();
    }
}

extern "C" void kernel_launch(void* const* d_in, const int* in_sizes, int n_in, void* d_out, int out_size, void* d_ws, size_t ws_size, hipStream_t stream) {
    static int grid_blocks = 0;
    if (grid_blocks == 0) {
        grid_blocks = -1;
        if (n_in != 21 || out_size != T * D || ws_size < WS_END) { fprintf(stderr, "kernel_launch: unexpected shapes (n_in %d, out %d, ws %zu)\n", n_in, out_size, ws_size); return; }
        if (hipFuncSetAttribute((const void*)mega, hipFuncAttributeMaxDynamicSharedMemorySize, LDS_BYTES) != hipSuccess) { fprintf(stderr, "kernel_launch: hipFuncSetAttribute failed\n"); return; }
        int dev = 0, cus = 0, per_cu = 0;
        if (hipGetDevice(&dev) != hipSuccess || hipDeviceGetAttribute(&cus, hipDeviceAttributeMultiprocessorCount, dev) != hipSuccess) { fprintf(stderr, "kernel_launch: device query failed\n"); return; }
        if (hipOccupancyMaxActiveBlocksPerMultiprocessor(&per_cu, (const void*)mega, NTHR, LDS_BYTES) != hipSuccess || per_cu < 1) { fprintf(stderr, "kernel_launch: occupancy query failed (%d)\n", per_cu); return; }
        grid_blocks = cus * 1;
    }
    if (grid_blocks < 0) return;
    Params hp{};
    hp.x = (const float*)d_in[0]; hp.c = (const float*)d_in[1]; hp.pos = (const int*)d_in[2]; hp.ada_w = (const float*)d_in[3]; hp.ada_b = (const float*)d_in[4];
    hp.w_in = (const float*)d_in[5]; hp.qg = (const float*)d_in[6]; hp.kvg = (const float*)d_in[7]; hp.w_uq = (const float*)d_in[8]; hp.w_ukv = (const float*)d_in[9];
    hp.conv_w = (const float*)d_in[10]; hp.w_o = (const float*)d_in[11]; hp.ln1_g = (const float*)d_in[12]; hp.ln1_b = (const float*)d_in[13]; hp.wq = (const float*)d_in[14];
    hp.k1 = (const float*)d_in[15]; hp.k2 = (const float*)d_in[16]; hp.pu = (const float*)d_in[17]; hp.pv = (const float*)d_in[18]; hp.ln2_g = (const float*)d_in[19]; hp.ln2_b = (const float*)d_in[20];
    hp.out = (float*)d_out; hp.ws = (unsigned char*)d_ws;
    void* args[] = {&hp};
    hipError_t e = hipLaunchCooperativeKernel((const void*)mega, dim3(grid_blocks), dim3(NTHR), args, LDS_BYTES, stream);
    if (e != hipSuccess) fprintf(stderr, "kernel_launch: cooperative launch failed: %s (grid %d)\n", hipGetErrorString(e), grid_blocks);
}
```
